# Optimizing an MI355X kernel written in HIP

```python
import math
import jax, jax.numpy as jnp
from jax import lax
import numpy as np

D_MODEL = 2048
BATCH = 32
SEQ = 256
DEPTH = 4
DEC_BATCH = 2
DEC_SEQ = 4096
PAST_LEN = 256

GRID_W = 64
HEAD_DIM = 128
MIX_W = D_MODEL
ATT_W = MIX_W // 2
ML_W = MIX_W // 4
DF_W = MIX_W // 4
ATT_HEADS = ATT_W // HEAD_DIM
ATT_KV_HEADS = 2
KV_W = ATT_KV_HEADS * HEAD_DIM
MLSTM_HEADS = ML_W // HEAD_DIM
DIFF_HEADS = DF_W // HEAD_DIM
DIFF_QK_DIM = HEAD_DIM // 2
N_DIR = 2
N_GATES = N_DIR * 2 * MLSTM_HEADS
D_FF = 4 * D_MODEL
QBLOCK = 128
MLSTM_CHUNK = 128
ROPE_THETA = 10000.0
EPS = 1e-6
SPLITS = (ATT_W, KV_W, KV_W, ML_W, ML_W, ML_W, ML_W, N_GATES, DF_W, DF_W, DF_W)
IN_W = sum(SPLITS)

kernel_name = 'hybrid_gqa_mlstm_diffattn_dit_step'


def rms_norm(x, g):
    xf = x.astype(jnp.float32)
    y = xf * lax.rsqrt(jnp.mean(xf * xf, axis=-1, keepdims=True) + EPS)
    return (y * g.astype(jnp.float32)).astype(x.dtype)


def axial_rope(n_tok, dim):
    rows = n_tok // GRID_W
    row_idx = jnp.repeat(jnp.arange(rows), GRID_W).astype(jnp.float32)
    col_idx = jnp.tile(jnp.arange(GRID_W), rows).astype(jnp.float32)
    n_freq = dim // 4
    inv = ROPE_THETA ** (-jnp.arange(n_freq, dtype=jnp.float32) / n_freq)
    ang = jnp.concatenate([row_idx[:, None] * inv, col_idx[:, None] * inv], axis=-1)
    return jnp.cos(ang), jnp.sin(ang)


def apply_rope(x, cos, sin):
    xf = x.astype(jnp.float32)
    half = x.shape[-1] // 2
    x1, x2 = xf[..., :half], xf[..., half:]
    c, s = cos[None, :, None, :], sin[None, :, None, :]
    return jnp.concatenate([x1 * c - x2 * s, x1 * s + x2 * c], axis=-1).astype(x.dtype)


def rope_two_maps(x, cos, sin):
    return jnp.concatenate([apply_rope(x[..., :DIFF_QK_DIM], cos, sin),
                            apply_rope(x[..., DIFF_QK_DIM:], cos, sin)], axis=-1)


def sweep_query_blocks(fn, *qs):
    b, n = qs[0].shape[:2]
    nb = n // QBLOCK
    blocks = tuple(jnp.moveaxis(q.reshape(b, nb, QBLOCK, *q.shape[2:]), 1, 0) for q in qs)
    out = lax.map(lambda blk: fn(*blk), blocks)
    out = jnp.moveaxis(out, 0, 1)
    return out.reshape(b, n, *out.shape[3:])


def gqa_attention(q, k, v):
    g = k.shape[2]
    scale = q.shape[-1] ** -0.5

    def block(qb):
        b, nq, h, d = qb.shape
        qg = qb.reshape(b, nq, g, h // g, d)
        s = jnp.einsum('bqgrd,btgd->bgrqt', qg, k).astype(jnp.float32) * scale
        p = jax.nn.softmax(s, axis=-1).astype(v.dtype)
        o = jnp.einsum('bgrqt,btgd->bqgrd', p, v)
        return o.reshape(b, nq, h, d)

    return sweep_query_blocks(block, q)


def diff_attention(q1, q2, k1, k2, v, lam):
    scale = q1.shape[-1] ** -0.5

    def block(qb1, qb2):
        s1 = jnp.einsum('bqhd,bthd->bhqt', qb1, k1).astype(jnp.float32) * scale
        s2 = jnp.einsum('bqhd,bthd->bhqt', qb2, k2).astype(jnp.float32) * scale
        p = jax.nn.softmax(s1, axis=-1) - lam * jax.nn.softmax(s2, axis=-1)
        return jnp.einsum('bhqt,bthe->bqhe', p.astype(v.dtype), v)

    return sweep_query_blocks(block, q1, q2)


def mlstm_scan(q, k, v, ig, lf, state):
    b, s, h, d = q.shape
    nc = s // MLSTM_CHUNK
    causal = jnp.tril(jnp.ones((MLSTM_CHUNK, MLSTM_CHUNK), dtype=bool))

    def to_chunks(a):
        return jnp.moveaxis(a.reshape(b, nc, MLSTM_CHUNK, *a.shape[2:]), 1, 0)

    def step(carry, xs):
        C, n, m = carry
        qc, kc, vc, ic, fc = xs
        bcum = jnp.cumsum(fc, axis=1)
        logw = bcum[:, :, None, :] - bcum[:, None, :, :] + ic[:, None, :, :]
        logw = jnp.where(causal[None, :, :, None], logw, -jnp.inf)
        inter = bcum + m[:, None, :]
        m_row = jnp.maximum(inter, jnp.max(logw, axis=2))
        sc = jnp.einsum('bjhd,bshd->bjsh', qc, kc) * jnp.exp(logw - m_row[:, :, None, :])
        a_inter = jnp.exp(inter - m_row)
        num = (jnp.einsum('bjsh,bshe->bjhe', sc, vc)
               + a_inter[..., None] * jnp.einsum('bjhd,bhde->bjhe', qc, C))
        den = jnp.sum(sc, axis=2) + a_inter * jnp.einsum('bjhd,bhd->bjh', qc, n)
        hc = num / jnp.maximum(jnp.abs(den), jnp.exp(-m_row))[..., None]
        m_new = m_row[:, -1]
        w_end = jnp.exp(bcum[:, -1:, :] - bcum + ic - m_new[:, None, :])
        decay = jnp.exp(bcum[:, -1] + m - m_new)
        C_new = decay[..., None, None] * C + jnp.einsum('bsh,bshd,bshe->bhde', w_end, kc, vc)
        n_new = decay[..., None] * n + jnp.einsum('bsh,bshd->bhd', w_end, kc)
        return (C_new, n_new, m_new), hc

    state, hs = lax.scan(step, state, tuple(to_chunks(a) for a in (q, k, v, ig, lf)))
    hs = jnp.moveaxis(hs, 0, 1).reshape(b, s, h, d)
    return hs, state


def mlstm_bidir(q, k, v, gates, st_f, st_b):
    flip = lambda a: jnp.flip(a, axis=1)
    ig = gates[:, :, :, 0]
    lf = jax.nn.log_sigmoid(gates[:, :, :, 1])
    h_f, st_f = mlstm_scan(q, k, v, ig[:, :, 0], lf[:, :, 0], st_f)
    h_b, st_b = mlstm_scan(flip(q), flip(k), flip(v), flip(ig[:, :, 1]), flip(lf[:, :, 1]), st_b)
    return h_f + flip(h_b), st_f, st_b


def mixing(hn, lp, layer, ctx):
    f32 = jnp.float32
    b, n, _ = hn.shape
    proj = hn @ lp['w_in']
    idx = np.cumsum(SPLITS)[:-1].tolist()
    aq, ak, av, mq, mk, mv, mo, mg, dq, dk, dv = jnp.split(proj, idx, axis=-1)
    heads = lambda a, h: a.reshape(b, n, h, HEAD_DIM)
    aq = rms_norm(heads(aq, ATT_HEADS), lp['qk_gain'][0])
    ak = rms_norm(heads(ak, ATT_KV_HEADS), lp['qk_gain'][1])
    av = heads(av, ATT_KV_HEADS)
    dq, dk, dv = heads(dq, DIFF_HEADS), heads(dk, DIFF_HEADS), heads(dv, DIFF_HEADS)
    mq = heads(mq, MLSTM_HEADS).astype(f32)
    mk = heads(mk, MLSTM_HEADS).astype(f32) * HEAD_DIM ** -0.5
    mv = heads(mv, MLSTM_HEADS).astype(f32)
    gates = mg.astype(f32).reshape(b, n, N_DIR, 2, MLSTM_HEADS) + lp['gate_bias'].astype(f32)

    if ctx is None:
        q_att, k_att, v_att = aq, ak, av
        q_dif, k_dif, v_dif = dq, dk, dv
        zero = (jnp.zeros((b, MLSTM_HEADS, HEAD_DIM, HEAD_DIM), f32),
                jnp.zeros((b, MLSTM_HEADS, HEAD_DIM), f32),
                jnp.full((b, MLSTM_HEADS), -jnp.inf, f32))
        st_f, st_b = zero, zero
    else:
        cos, sin = axial_rope(n, HEAD_DIM)
        cos2, sin2 = axial_rope(n, DIFF_QK_DIM)
        q_att = apply_rope(aq, cos, sin)
        k_att = jnp.concatenate([apply_rope(ak, cos, sin), ctx['gqa_k'].astype(ak.dtype)], axis=1)
        v_att = jnp.concatenate([av, ctx['gqa_v'].astype(av.dtype)], axis=1)
        q_dif = rope_two_maps(dq, cos2, sin2)
        k_dif = jnp.concatenate([rope_two_maps(dk, cos2, sin2), ctx['diff_k'].astype(dk.dtype)], axis=1)
        v_dif = jnp.concatenate([dv, ctx['diff_v'].astype(dv.dtype)], axis=1)
        st_f = (ctx['C'][:, 0].astype(f32), ctx['n'][:, 0].astype(f32), ctx['m'][:, 0].astype(f32))
        st_b = (ctx['C'][:, 1].astype(f32), ctx['n'][:, 1].astype(f32), ctx['m'][:, 1].astype(f32))

    att_out = gqa_attention(q_att, k_att, v_att)

    lam_init = 0.8 - 0.6 * math.exp(-0.3 * layer)
    lv = lp['diff_lambda'].astype(f32)
    lam = jnp.exp(jnp.sum(lv[0] * lv[1])) - jnp.exp(jnp.sum(lv[2] * lv[3])) + lam_init
    dif_out = diff_attention(q_dif[..., :DIFF_QK_DIM], q_dif[..., DIFF_QK_DIM:],
                             k_dif[..., :DIFF_QK_DIM], k_dif[..., DIFF_QK_DIM:], v_dif, lam)
    dif_out = rms_norm(dif_out, lp['diff_gain']) * (1.0 - lam_init)

    h_ml, st_f, st_b = mlstm_bidir(mq, mk, mv, gates, st_f, st_b)
    o_gate = jax.nn.sigmoid(mo.astype(f32)).reshape(b, n, MLSTM_HEADS, HEAD_DIM)
    h_ml = rms_norm(h_ml, lp['ml_gain']) * o_gate

    cat = jnp.concatenate([att_out.reshape(b, n, ATT_W),
                           h_ml.reshape(b, n, ML_W).astype(hn.dtype),
                           dif_out.reshape(b, n, DF_W)], axis=-1)
    out = cat @ lp['w_out']
    if ctx is None:
        dt = hn.dtype
        new_ctx = (ak, av, dk, dv,
                   jnp.stack([st_f[0], st_b[0]], axis=1).astype(dt),
                   jnp.stack([st_f[1], st_b[1]], axis=1).astype(dt),
                   jnp.stack([st_f[2], st_b[2]], axis=1).astype(dt))
    else:
        new_ctx = None
    return out, new_ctx


def trunk_layer(x, cond, lp, layer, ctx):
    mod = jax.nn.silu(cond) @ lp['w_ada'] + lp['b_ada']
    sh1, sc1, g1, sh2, sc2, g2 = (m[:, None, :] for m in jnp.split(mod, 6, axis=-1))
    g = lp['norm_gain']
    hn = rms_norm(x, g[0]) * (1 + sc1) + sh1
    mix, new_ctx = mixing(hn, lp, layer, ctx)
    x = x + g1 * rms_norm(mix, g[1])
    hn = rms_norm(x, g[2]) * (1 + sc2) + sh2
    ff = jnp.square(jax.nn.relu(hn @ lp['w_ff1'])) @ lp['w_ff2']
    x = x + g2 * rms_norm(ff, g[3])
    return x, new_ctx


def setup_inputs(seed: int = 0) -> dict:
    key = jax.random.key(seed)
    ks = jax.random.split(key, 24)
    f32 = jnp.float32
    nrm = lambda k, shape, s=1.0: jax.random.normal(k, shape, f32) * s
    gate_base = jnp.array([0.0, 3.0], f32)[None, None, :, None]
    gate_scale = jnp.array([0.1, 0.5], f32)[None, None, :, None]
    return {
        'x_prompt': nrm(ks[0], (BATCH, SEQ, D_MODEL)),
        'x_sample': nrm(ks[1], (DEC_BATCH, DEC_SEQ, D_MODEL)),
        'c': nrm(ks[2], (DEC_BATCH, D_MODEL)),
        'cache_gqa_k': nrm(ks[3], (DEC_BATCH, DEPTH, PAST_LEN, ATT_KV_HEADS, HEAD_DIM)),
        'cache_gqa_v': nrm(ks[4], (DEC_BATCH, DEPTH, PAST_LEN, ATT_KV_HEADS, HEAD_DIM)),
        'cache_diff_k': nrm(ks[5], (DEC_BATCH, DEPTH, PAST_LEN, DIFF_HEADS, HEAD_DIM)),
        'cache_diff_v': nrm(ks[6], (DEC_BATCH, DEPTH, PAST_LEN, DIFF_HEADS, HEAD_DIM)),
        'state_mlstm_C': nrm(ks[7], (DEC_BATCH, DEPTH, N_DIR, MLSTM_HEADS, HEAD_DIM, HEAD_DIM), 0.1),
        'state_mlstm_n': nrm(ks[8], (DEC_BATCH, DEPTH, N_DIR, MLSTM_HEADS, HEAD_DIM), 0.1),
        'state_mlstm_m': nrm(ks[9], (DEC_BATCH, DEPTH, N_DIR, MLSTM_HEADS), 0.5),
        'c_ctx': nrm(ks[10], (D_MODEL,)),
        'w_ada': nrm(ks[11], (DEPTH, D_MODEL, 6 * D_MODEL), 0.5 * D_MODEL ** -0.5),
        'b_ada': nrm(ks[12], (DEPTH, 6 * D_MODEL), 0.02),
        'norm_gain': 1.0 + nrm(ks[13], (DEPTH, 4, D_MODEL), 0.02),
        'w_in': nrm(ks[14], (DEPTH, D_MODEL, IN_W), D_MODEL ** -0.5),
        'w_out': nrm(ks[15], (DEPTH, MIX_W, D_MODEL), MIX_W ** -0.5),
        'qk_gain': 1.0 + nrm(ks[16], (DEPTH, 2, HEAD_DIM), 0.02),
        'mlstm_gate_bias': gate_base + gate_scale * nrm(ks[17], (DEPTH, N_DIR, 2, MLSTM_HEADS)),
        'mlstm_head_gain': 1.0 + nrm(ks[18], (DEPTH, MLSTM_HEADS, HEAD_DIM), 0.02),
        'diff_lambda': nrm(ks[19], (DEPTH, 4, DIFF_QK_DIM), 0.1),
        'diff_head_gain': 1.0 + nrm(ks[20], (DEPTH, HEAD_DIM), 0.02),
        'w_ff1': nrm(ks[21], (DEPTH, D_MODEL, D_FF), D_MODEL ** -0.5),
        'w_ff2': nrm(ks[22], (DEPTH, D_FF, D_MODEL), D_FF ** -0.5),
    }


def reference(x_prompt, x_sample, c, cache_gqa_k, cache_gqa_v, cache_diff_k, cache_diff_v,
              state_mlstm_C, state_mlstm_n, state_mlstm_m, c_ctx, w_ada, b_ada, norm_gain,
              w_in, w_out, qk_gain, mlstm_gate_bias, mlstm_head_gain, diff_lambda,
              diff_head_gain, w_ff1, w_ff2):
    def layer_params(l):
        return {'w_ada': w_ada[l], 'b_ada': b_ada[l], 'norm_gain': norm_gain[l],
                'w_in': w_in[l], 'w_out': w_out[l], 'qk_gain': qk_gain[l],
                'gate_bias': mlstm_gate_bias[l], 'ml_gain': mlstm_head_gain[l],
                'diff_lambda': diff_lambda[l], 'diff_gain': diff_head_gain[l],
                'w_ff1': w_ff1[l], 'w_ff2': w_ff2[l]}

    xp = x_prompt
    collected = [[] for _ in range(7)]
    for l in range(DEPTH):
        xp, ctx_t = trunk_layer(xp, c_ctx[None, :], layer_params(l), l, None)
        for lst, t in zip(collected, ctx_t):
            lst.append(t)
    y_prompt = xp
    new_gqa_k, new_gqa_v, new_diff_k, new_diff_v, new_mlstm_C, new_mlstm_n, new_mlstm_m = (
        jnp.stack(lst, axis=1) for lst in collected)

    xs = x_sample
    for l in range(DEPTH):
        ctx = {'gqa_k': cache_gqa_k[:, l], 'gqa_v': cache_gqa_v[:, l],
               'diff_k': cache_diff_k[:, l], 'diff_v': cache_diff_v[:, l],
               'C': state_mlstm_C[:, l], 'n': state_mlstm_n[:, l], 'm': state_mlstm_m[:, l]}
        xs, _ = trunk_layer(xs, c, layer_params(l), l, ctx)
    y_sample = xs

    return (y_prompt, y_sample, new_gqa_k, new_gqa_v, new_diff_k, new_diff_v,
            new_mlstm_C, new_mlstm_n, new_mlstm_m)
```

```cpp
#include <hip/hip_runtime.h>
#ifndef REP_GEMM
#define REP_GEMM 1
#endif
#ifndef REP_ML
#define REP_ML 1
#endif
#ifndef REP_P6
#define REP_P6 1
#endif
#ifndef REP_P0
#define REP_P0 1
#endif
#ifndef REP_T1
#define REP_T1 1
#endif
#ifndef REP_BAR
#define REP_BAR 1
#endif
#ifndef REP_P2
#define REP_P2 1
#endif
#ifndef REP_P3
#define REP_P3 1
#endif
#ifndef REP_ATT
#define REP_ATT 1
#endif
#include <cstdio>
#include <cstdint>
namespace pg8 {
#define PG8_LAS __attribute__((address_space(3)))
typedef unsigned short bf16_t;
typedef short bf16x8 __attribute__((ext_vector_type(8)));
typedef float f32x4 __attribute__((ext_vector_type(4)));
typedef unsigned u32x4 __attribute__((ext_vector_type(4)));
constexpr int BM = 256, BK = 64, HALF = 128, HTB = HALF * BK * 2  , STAGE_BYTES = 8 * HTB, NXCD = 8, WGM = 8;

__host__ __device__ __forceinline__ int lds_byte(int r, int c) { const int st = (r >> 4) * 2 + (c >> 5), rr = r & 15, cc = c & 31, ob = rr * 64 + cc * 2; return st * 1024 + (ob ^ (((ob >> 9) & 1) << 5)); }
__host__ __device__ __forceinline__ void stage_rc(int b, int& R, int& C) { const int st = b / 1024, sb = b % 1024, swz = sb ^ (((sb >> 9) & 1) << 5); R = (st >> 1) * 16 + swz / 64; C = (st & 1) * 32 + (swz % 64) / 2; }
__host__ __device__ __forceinline__ int perm32(int rho) { const int n = rho >> 4, i = rho & 15; return 8 * (i >> 2) + 4 * n + (i & 3); }

struct Unit { int pm, pn; };
struct Gemm { const bf16_t* A; const bf16_t* Bt; int M, N, K; };

struct StaticOrder {
    int nM, nN, nwg, G, c;
    __host__ __device__ void init(int M, int N, int G_, int c_) { nM = M / BM; nN = N / BM; nwg = nM * nN; G = G_; c = c_; }
    __host__ __device__ bool next(int i, Unit& u) const {
        const long L = (long)i * G + c; if (L >= nwg) return false;
        int wgid = (int)L; { const int q = nwg / NXCD, r = nwg % NXCD, xcd = wgid % NXCD, off = wgid / NXCD; wgid = (xcd < r ? xcd * (q + 1) : r * (q + 1) + (xcd - r) * q) + off; }
        const int nig = WGM * nN, gid = wgid / nig, fm = gid * WGM, gsz = (nM - fm) < WGM ? (nM - fm) : WGM;
        u.pm = fm + ((wgid % nig) % gsz); u.pn = (wgid % nig) / gsz; return true;
    }
    __device__ __forceinline__ void a_ready(const Unit&) const {}
    __device__ __forceinline__ void done(const Unit&) const {}
};

__device__ __forceinline__ unsigned cvt_pk_bf16(float lo, float hi) { unsigned r; asm volatile("v_cvt_pk_bf16_f32 %0, %1, %2" : "=v"(r) : "v"(lo), "v"(hi)); return r; }
typedef float f32x2 __attribute__((ext_vector_type(2)));
template <int ACT  > struct EpiBf16 {
    static constexpr bool PERM = true, AFTER_DRAIN = false;
    bf16_t* O; int ldc;
    __device__ __forceinline__ void operator()(const f32x4 (&acc)[2][2][4][2], const Unit& u, int wr, int wc, int fr, int fq) const {
        const int row0 = u.pm * BM + wr * 64 + fr; const int col0 = u.pn * BM + wc * 32 + 8 * fq;
#pragma unroll
        for (int ai = 0; ai < 2; ++ai)
#pragma unroll
            for (int m = 0; m < 4; ++m) { bf16_t* rowp = O + (size_t)(row0 + ai * HALF + m * 16) * ldc + col0;
#pragma unroll
                for (int bj = 0; bj < 2; ++bj) { f32x4 v0 = acc[ai][bj][m][0], v1 = acc[ai][bj][m][1];
                    if (ACT == 2) {
#pragma unroll
                        for (int e = 0; e < 4; ++e) { const float a = fmaxf(v0[e], 0.f), b = fmaxf(v1[e], 0.f); v0[e] = a * a; v1[e] = b * b; } }
                    u32x4 w; w.x = cvt_pk_bf16(v0[0], v0[1]); w.y = cvt_pk_bf16(v0[2], v0[3]); w.z = cvt_pk_bf16(v1[0], v1[1]); w.w = cvt_pk_bf16(v1[2], v1[3]);
                    *(u32x4*)(rowp + bj * HALF) = w; } }
    }
};

template <class Epi, class Sched, bool ALIGN_EPI = false, bool SP2 = false>
__device__ __forceinline__ void gemm_phase(PG8_LAS unsigned char* lds, const Gemm g, const Sched& S, const Epi& E) {
    int tid_o = threadIdx.x; asm volatile("" : "+v"(tid_o));
    const int tid = tid_o, wid = __builtin_amdgcn_readfirstlane(tid >> 6), lane = tid & 63, wr = wid >> 2, wc = wid & 3, fr = lane & 15, fq = lane >> 4;
    const int K = g.K, nt = K / BK;
    unsigned voffA[2], voffB[2];
#pragma unroll
    for (int i = 0; i < 2; ++i) { int R, C; stage_rc(tid * 16 + i * 8192, R, C); const int Rb = Epi::PERM ? ((R & ~31) + perm32(R & 31)) : R;
        voffA[i] = (unsigned)(R * K + C) * 2u; voffB[i] = (unsigned)(Rb * K + C) * 2u; }
    const size_t kstep = (size_t)(BK * 2);
    const size_t hstep = (size_t)HALF * K * 2;
    const size_t tstep = 2 * hstep;
    const unsigned ldsw = (unsigned)wid * 1024u;
    const int aoff = lds_byte(wr * 64 + fr, fq * 8), boff = lds_byte(wc * 32 + fr, fq * 8);
#define PG8_SA(b, h) (((b) * 2 + (h)) * HTB)
#define PG8_SB(b, h) ((4 + (b) * 2 + (h)) * HTB)
#define PG8_STAGE(bufoff, gbase, voff) do { _Pragma("unroll") for (int _i = 0; _i < 2; ++_i) \
        __builtin_amdgcn_global_load_lds((const unsigned*)((const char*)(gbase) + (voff)[_i]), (PG8_LAS unsigned*)(lds + (bufoff) + ldsw + _i * 8192), 16, 0, 0); } while (0)
#define PG8_LDA(dst, b, h) do { _Pragma("unroll") for (int m = 0; m < 4; ++m) _Pragma("unroll") for (int k = 0; k < 2; ++k) dst[m][k] = *(const PG8_LAS bf16x8*)(lds + PG8_SA(b, h) + aoff + m * 2048 + k * 1024); } while (0)
#define PG8_LDB(dst, b, h) do { _Pragma("unroll") for (int n = 0; n < 2; ++n) _Pragma("unroll") for (int k = 0; k < 2; ++k) dst[n][k] = *(const PG8_LAS bf16x8*)(lds + PG8_SB(b, h) + boff + n * 2048 + k * 1024); } while (0)
#define PG8_MMA(ai, bj, At, Bt) do { __builtin_amdgcn_s_setprio(1); _Pragma("unroll") for (int m = 0; m < 4; ++m) _Pragma("unroll") for (int n = 0; n < 2; ++n) _Pragma("unroll") for (int k = 0; k < 2; ++k) \
        acc[ai][bj][m][n] = __builtin_amdgcn_mfma_f32_16x16x32_bf16(Bt[n][k], At[m][k], acc[ai][bj][m][n], 0, 0, 0); __builtin_amdgcn_s_setprio(0); } while (0)
#define PG8_WAIT_V(n) asm volatile("s_waitcnt vmcnt(" #n ")" ::: "memory")
#define PG8_WAIT_L(n) asm volatile("s_waitcnt lgkmcnt(" #n ")" ::: "memory")
#define PG8_BAR __builtin_amdgcn_s_barrier()
#define PG8_SCHED __builtin_amdgcn_sched_barrier(0)
    Unit cur, nxt; int ui = 0;
    if (!S.next(0, cur)) return;
    f32x4 acc[2][2][4][2];
#pragma unroll
    for (int a = 0; a < 2; ++a)
#pragma unroll
        for (int b = 0; b < 2; ++b)
#pragma unroll
            for (int m = 0; m < 4; ++m)
#pragma unroll
                for (int n = 0; n < 2; ++n) acc[a][b][m][n] = (f32x4){0.f, 0.f, 0.f, 0.f};
    bf16x8 At[4][2], B0[2][2], B1[2][2];
    const char* cA = (const char*)g.A + (size_t)cur.pm * tstep; const char* cB = (const char*)g.Bt + (size_t)cur.pn * tstep;
    S.a_ready(cur);
    if constexpr (SP2) {
        PG8_STAGE(PG8_SB(0, 0), cB, voffB); PG8_STAGE(PG8_SB(0, 1), cB + hstep, voffB); PG8_STAGE(PG8_SA(0, 0), cA, voffA); PG8_STAGE(PG8_SA(0, 1), cA + hstep, voffA);
        if (wr == 1) PG8_BAR;
        PG8_WAIT_V(2); PG8_BAR;
        PG8_STAGE(PG8_SB(1, 0), cB + kstep, voffB); PG8_STAGE(PG8_SA(1, 0), cA + kstep, voffA); PG8_STAGE(PG8_SB(1, 1), cB + hstep + kstep, voffB);
        PG8_WAIT_V(6); PG8_BAR;
    } else {
        PG8_STAGE(PG8_SB(0, 0), cB, voffB); PG8_STAGE(PG8_SA(0, 0), cA, voffA); PG8_STAGE(PG8_SB(0, 1), cB + hstep, voffB); PG8_STAGE(PG8_SA(0, 1), cA + hstep, voffA);
        if (wr == 1) PG8_BAR;
        PG8_WAIT_V(4); PG8_BAR;
        PG8_STAGE(PG8_SB(1, 0), cB + kstep, voffB); PG8_STAGE(PG8_SA(1, 0), cA + kstep, voffA); PG8_STAGE(PG8_SB(1, 1), cB + hstep + kstep, voffB);
        PG8_WAIT_V(6); PG8_BAR;
    }
    for (;;) {
        const bool has_next = S.next(ui + 1, nxt);
        const char* nA = has_next ? (const char*)g.A + (size_t)nxt.pm * tstep : cA; const char* nB = has_next ? (const char*)g.Bt + (size_t)nxt.pn * tstep : cB;
        for (int t = 0; t < nt; t += 2) {
            const bool last = (t == nt - 2);
            const char* a1 = cA + (size_t)(t + 1) * kstep;
            const char* a2 = last ? nA : cA + (size_t)(t + 2) * kstep; const char* b2 = last ? nB : cB + (size_t)(t + 2) * kstep;
            const char* a3 = a2 + kstep; const char* b3 = b2 + kstep;
            if (last && has_next) S.a_ready(nxt);
            if constexpr (SP2) {
            PG8_LDB(B0, 0, 0); PG8_LDB(B1, 0, 1); PG8_SCHED; PG8_LDA(At, 0, 0); PG8_STAGE(PG8_SA(1, 1), a1 + hstep, voffA);
            PG8_WAIT_V(8); PG8_WAIT_L(0); PG8_BAR; PG8_MMA(0, 0, At, B0); PG8_MMA(0, 1, At, B1); PG8_BAR; PG8_SCHED;
            PG8_LDA(At, 0, 1); PG8_STAGE(PG8_SB(0, 0), b2, voffB); PG8_STAGE(PG8_SB(0, 1), b2 + hstep, voffB); PG8_STAGE(PG8_SA(0, 0), a2, voffA);
            PG8_WAIT_V(8); PG8_WAIT_L(0); PG8_BAR; PG8_MMA(1, 0, At, B0); PG8_MMA(1, 1, At, B1); PG8_BAR; PG8_SCHED;
            PG8_LDB(B0, 1, 0); PG8_LDB(B1, 1, 1); PG8_SCHED; PG8_LDA(At, 1, 0); PG8_STAGE(PG8_SA(0, 1), a2 + hstep, voffA);
            PG8_WAIT_V(8); PG8_WAIT_L(0); PG8_BAR; PG8_MMA(0, 0, At, B0); PG8_MMA(0, 1, At, B1); PG8_BAR; PG8_SCHED;
            PG8_LDA(At, 1, 1); PG8_STAGE(PG8_SB(1, 0), b3, voffB); PG8_STAGE(PG8_SB(1, 1), b3 + hstep, voffB); PG8_STAGE(PG8_SA(1, 0), a3, voffA);
            PG8_WAIT_V(8); PG8_WAIT_L(0); PG8_BAR; PG8_MMA(1, 0, At, B0); PG8_MMA(1, 1, At, B1); PG8_BAR; PG8_SCHED;
            } else {
            PG8_LDB(B0, 0, 0); PG8_SCHED; PG8_LDA(At, 0, 0); PG8_STAGE(PG8_SA(1, 1), a1 + hstep, voffA);
            PG8_WAIT_L(8); PG8_BAR; PG8_WAIT_L(0); PG8_MMA(0, 0, At, B0); PG8_BAR; PG8_SCHED;
            PG8_LDB(B1, 0, 1); PG8_STAGE(PG8_SB(0, 0), b2, voffB);
            PG8_BAR; PG8_WAIT_L(0); PG8_MMA(0, 1, At, B1); PG8_BAR;
            PG8_LDA(At, 0, 1); PG8_STAGE(PG8_SA(0, 0), a2, voffA);
            PG8_BAR; PG8_WAIT_L(0); PG8_MMA(1, 0, At, B0); PG8_BAR; PG8_SCHED;
            PG8_STAGE(PG8_SB(0, 1), b2 + hstep, voffB);
            PG8_WAIT_V(6); PG8_BAR; PG8_MMA(1, 1, At, B1); PG8_BAR;
            PG8_LDB(B0, 1, 0); PG8_SCHED; PG8_LDA(At, 1, 0); PG8_STAGE(PG8_SA(0, 1), a2 + hstep, voffA);
            PG8_WAIT_L(8); PG8_BAR; PG8_WAIT_L(0); PG8_MMA(0, 0, At, B0); PG8_BAR; PG8_SCHED;
            PG8_LDB(B1, 1, 1); PG8_STAGE(PG8_SB(1, 0), b3, voffB);
            PG8_BAR; PG8_WAIT_L(0); PG8_MMA(0, 1, At, B1); PG8_BAR;
            PG8_LDA(At, 1, 1); PG8_STAGE(PG8_SA(1, 0), a3, voffA);
            PG8_BAR; PG8_WAIT_L(0); PG8_MMA(1, 0, At, B0); PG8_BAR; PG8_SCHED;
            PG8_STAGE(PG8_SB(1, 1), b3 + hstep, voffB);
            PG8_WAIT_V(6); PG8_BAR; PG8_MMA(1, 1, At, B1); PG8_BAR;
            }
        }
        if constexpr (ALIGN_EPI) { if (wr == 0) PG8_BAR; }
        if constexpr (!Epi::AFTER_DRAIN) { E(acc, cur, wr, wc, fr, fq); S.done(cur); }
        if (!has_next) break;
#pragma unroll
        for (int a = 0; a < 2; ++a)
#pragma unroll
            for (int b = 0; b < 2; ++b)
#pragma unroll
                for (int m = 0; m < 4; ++m)
#pragma unroll
                    for (int n = 0; n < 2; ++n) acc[a][b][m][n] = (f32x4){0.f, 0.f, 0.f, 0.f};
        cur = nxt; cA = nA; cB = nB; ++ui;
        if constexpr (ALIGN_EPI) { if (wr == 1) PG8_BAR; }
    }
    PG8_WAIT_V(0);
    if constexpr (!ALIGN_EPI) { if (wr == 0) PG8_BAR; }
    PG8_BAR;
    if constexpr (Epi::AFTER_DRAIN) { E.fused(acc, cur, wr, wc, fr, fq, lds, wid, lane); S.done(cur); }
#undef PG8_SA
#undef PG8_SB
#undef PG8_STAGE
#undef PG8_LDA
#undef PG8_LDB
#undef PG8_MMA
#undef PG8_WAIT_V
#undef PG8_WAIT_L
#undef PG8_BAR
#undef PG8_SCHED
}
}
namespace att {
typedef unsigned short bf16;
using bf16x8 = __attribute__((ext_vector_type(8))) short;
using s16x4  = __attribute__((ext_vector_type(4))) short;
using f32x16 = __attribute__((ext_vector_type(16))) float;
using u32x4  = __attribute__((ext_vector_type(4))) unsigned;
constexpr int   D = 128, NW = 8, QBLK = 32, KVBLK = 64;
constexpr size_t SHM_V = KVBLK * D * 2, SHM_K = KVBLK * D * 2, SHM_ATTN = 2 * SHM_V + 2 * SHM_K + NW * 64 * 4;
constexpr int SDEPTH = 2;
#define KSWZ(row, colB) ((row) * 256 + ((colB) ^ (((row) & 7) << 4)))
#define SBAR() __builtin_amdgcn_sched_barrier(0)
__device__ __forceinline__ int crow(int r, int hi) { return (r & 3) + 8 * (r >> 2) + 4 * hi; }
__device__ __forceinline__ unsigned cvtpk(float lo, float hi) {
  unsigned r; asm volatile("v_cvt_pk_bf16_f32 %0, %1, %2" : "=v"(r) : "v"(lo), "v"(hi)); return r;
}
__device__ __forceinline__ bf16x8 ld8(const bf16* p) { return *reinterpret_cast<const bf16x8*>(p); }

__device__ __forceinline__ void partialSM(f32x16& p0, f32x16& p1, float& m_reg, float& mn, float& alpha, const float C, const float thr) {
  float pmax = p0[0];
#pragma unroll
  for (int r = 1; r < 16; ++r) pmax = fmaxf(pmax, p0[r]);
#pragma unroll
  for (int r = 0; r < 16; ++r) pmax = fmaxf(pmax, p1[r]);
  { auto rr = __builtin_amdgcn_permlane32_swap(__float_as_uint(pmax), __float_as_uint(pmax), false, false);
    pmax = fmaxf(__uint_as_float(rr[0]), __uint_as_float(rr[1])); }
  if (__builtin_expect(__all(pmax - m_reg <= thr), 1)) { mn = m_reg; alpha = 1.f; }
  else { mn = fmaxf(m_reg, pmax); alpha = __builtin_amdgcn_exp2f((m_reg - mn) * C); m_reg = mn; }
  float mnC = -mn * C;
#pragma unroll
  for (int r = 0; r < 16; ++r) p0[r] = fmaf(p0[r], C, mnC);
#pragma unroll
  for (int r = 0; r < 16; ++r) p1[r] = fmaf(p1[r], C, mnC);
#pragma unroll
  for (int r = 0; r < 16; ++r) p0[r] = __builtin_amdgcn_exp2f(p0[r]);
}
__device__ __forceinline__ void finishSM(f32x16& p0, f32x16& p1, float alpha, float& l_reg, bf16x8& pa0, bf16x8& pa1, bf16x8& pa2, bf16x8& pa3) {
#pragma unroll
  for (int r = 0; r < 16; ++r) p1[r] = __builtin_amdgcn_exp2f(p1[r]);
  float ps = 0;
#pragma unroll
  for (int r = 0; r < 16; ++r) ps += p0[r];
#pragma unroll
  for (int r = 0; r < 16; ++r) ps += p1[r];
  { auto rr = __builtin_amdgcn_permlane32_swap(__float_as_uint(ps), __float_as_uint(ps), false, false);
    ps = __uint_as_float(rr[0]) + __uint_as_float(rr[1]); }
  l_reg = l_reg * alpha + ps;
#define PK4(P, BASE, OUT) do { unsigned a0 = cvtpk(P[BASE + 0], P[BASE + 1]), a1 = cvtpk(P[BASE + 2], P[BASE + 3]);   \
    unsigned b0 = cvtpk(P[BASE + 4], P[BASE + 5]), b1 = cvtpk(P[BASE + 6], P[BASE + 7]);                              \
    auto r0 = __builtin_amdgcn_permlane32_swap(a0, b0, false, false); auto r1 = __builtin_amdgcn_permlane32_swap(a1, b1, false, false); \
    u32x4 w = {r0[0], r1[0], r0[1], r1[1]}; OUT = *reinterpret_cast<bf16x8*>(&w); } while (0)
  PK4(p0, 0, pa0); PK4(p0, 8, pa1); PK4(p1, 0, pa2); PK4(p1, 8, pa3);
#undef PK4
}
template <int ND> __device__ __forceinline__ void qkt(f32x16& p0, f32x16& p1, const bf16* Ks, const bf16x8* qr, int r32, int hi, const int kofsB) {
  p0 = f32x16{}; p1 = f32x16{};
#pragma unroll
  for (int d0 = 0; d0 < ND; ++d0) { int cb = (d0 * 16 + hi * 8) * 2 + kofsB;
    bf16x8 b0 = *reinterpret_cast<const bf16x8*>((const char*)Ks + KSWZ(r32, cb));
    bf16x8 b1 = *reinterpret_cast<const bf16x8*>((const char*)Ks + KSWZ(32 + r32, cb));
    p0 = __builtin_amdgcn_mfma_f32_32x32x16_bf16(b0, qr[d0], p0, 0, 0, 0);
    p1 = __builtin_amdgcn_mfma_f32_32x32x16_bf16(b1, qr[d0], p1, 0, 0, 0); }
}
__device__ __forceinline__ int v_st(int k, int c) { const int kk = (k & ~0xC) | ((k & 4) << 1) | ((k & 8) >> 1); return ((kk >> 3) * 4 + (c >> 5)) * 512 + ((kk & 7) * 32 + (c & 31)) * 2; }
__device__ __forceinline__ int v_rd_base(int lane) { return ((lane & 3) << 3) | (((lane >> 2) & 3) << 6) | (((lane >> 4) & 1) << 5) | (((lane >> 5) & 1) << 8); }
constexpr int v_rd_off(int d0, int ks, int half) { return d0 * 512 + ks * 4096 + half * 2048; }
template <int OFF> __device__ __forceinline__ s16x4 tr_read(int vb) {
  s16x4 r; asm volatile("ds_read_b64_tr_b16 %0, %1 offset:%2" : "=&v"(r) : "v"(vb), "i"(OFF) : "memory"); return r;
}
template <int D0> __device__ __forceinline__ void pv_one(f32x16& od, int vb, bf16x8 pa0, bf16x8 pa1, bf16x8 pa2, bf16x8 pa3) {
  const s16x4 l0 = tr_read<v_rd_off(D0, 0, 0)>(vb), h0 = tr_read<v_rd_off(D0, 0, 1)>(vb), l1 = tr_read<v_rd_off(D0, 1, 0)>(vb), h1 = tr_read<v_rd_off(D0, 1, 1)>(vb);
  const s16x4 l2 = tr_read<v_rd_off(D0, 2, 0)>(vb), h2 = tr_read<v_rd_off(D0, 2, 1)>(vb), l3 = tr_read<v_rd_off(D0, 3, 0)>(vb), h3 = tr_read<v_rd_off(D0, 3, 1)>(vb);
  asm volatile("s_waitcnt lgkmcnt(0)" ::: "memory"); SBAR();
#define PK(L, H) (bf16x8){L[0], L[1], L[2], L[3], H[0], H[1], H[2], H[3]}
  od = __builtin_amdgcn_mfma_f32_32x32x16_bf16(pa0, PK(l0, h0), od, 0, 0, 0);
  od = __builtin_amdgcn_mfma_f32_32x32x16_bf16(pa1, PK(l1, h1), od, 0, 0, 0);
  od = __builtin_amdgcn_mfma_f32_32x32x16_bf16(pa2, PK(l2, h2), od, 0, 0, 0);
  od = __builtin_amdgcn_mfma_f32_32x32x16_bf16(pa3, PK(l3, h3), od, 0, 0, 0);
#undef PK
}
__device__ __forceinline__ void pv_d0(f32x16* o, int vb, bf16x8 pa0, bf16x8 pa1, bf16x8 pa2, bf16x8 pa3) {
  pv_one<0>(o[0], vb, pa0, pa1, pa2, pa3); pv_one<1>(o[1], vb, pa0, pa1, pa2, pa3); pv_one<2>(o[2], vb, pa0, pa1, pa2, pa3); pv_one<3>(o[3], vb, pa0, pa1, pa2, pa3);
}
__device__ __forceinline__ unsigned short f2bf_rne(float f) { unsigned u = __builtin_bit_cast(unsigned, f); return (unsigned short)((u + 0x7fffu + ((u >> 16) & 1u)) >> 16); }

__device__ __forceinline__ float bfu(short v) { return __builtin_bit_cast(float, (unsigned)(unsigned short)v << 16); }
__device__ __forceinline__ bf16x8 pack8(const float* x) { u32x4 w = {cvtpk(x[0], x[1]), cvtpk(x[2], x[3]), cvtpk(x[4], x[5]), cvtpk(x[6], x[7])}; return *reinterpret_cast<bf16x8*>(&w); }
#define ROPE_PAIR(BA, BB, POS, F0, NF) do { float xa[8], xb[8]; _Pragma("unroll") for (int e = 0; e < 8; ++e) { xa[e] = bfu(qr[BA][e]); xb[e] = bfu(qr[BB][e]); \
    const float ang = (POS) * exp2f(-(float)((F0) + e) * (13.287712379549449f / (NF))); const float c = __cosf(ang), s = __sinf(ang); \
    const float ra = xa[e] * c - xb[e] * s, rb = xa[e] * s + xb[e] * c; xa[e] = ra; xb[e] = rb; } qr[BA] = pack8(xa); qr[BB] = pack8(xb); } while (0)
template <bool HALF> __device__ __forceinline__ void attn_dense_body(const bf16* __restrict__ Qb, const int ldq, const int qmode, const float* __restrict__ qgain, const int qrope, const int t0,
                                                const bf16* __restrict__ Kh, const bf16* __restrict__ Vh, const int ldk,
                                                bf16* __restrict__ Ob, const int ldo, const int seq, const float C, const float thr, char* lds,
                                                const bf16* O1b = nullptr, const float lam = 0.f, const float* __restrict__ cgain = nullptr, const float cscale = 0.f) {
  int tid_o = threadIdx.x; asm volatile("" : "+v"(tid_o));
  const int tid = tid_o, wid = tid >> 6, lane = tid & 63, r32 = lane & 31, hi = lane >> 5;
  bf16* V_lds = (bf16*)lds; bf16* K_lds = (bf16*)(lds + 2 * SHM_V);
  float* ws = (float*)(lds + 2 * SHM_V + 2 * SHM_K) + wid * 64; float* li_l = ws; float* al_l = ws + 32;
  constexpr int ND = HALF ? 4 : 8;
  float m_reg = -1e30f, l_reg = 0; f32x16 o[4] = {}; bf16x8 qr[ND];
  const int qoff = HALF ? ((qmode == 2) ? 64 : 0) : 0; const int kofsB = qoff * 2;
  const bf16* Qw = Qb + (long)(wid * QBLK + r32) * ldq + qoff + hi * 8;
#pragma unroll
  for (int d0 = 0; d0 < ND; ++d0) qr[d0] = ld8(Qw + d0 * 16);
  if constexpr (!HALF) {
    if (qgain != nullptr) {
      float ss = 0.f;
#pragma unroll
      for (int d0 = 0; d0 < 8; ++d0)
#pragma unroll
        for (int e = 0; e < 8; ++e) { const float x = bfu(qr[d0][e]); ss += x * x; }
      ss += __shfl_xor(ss, 32);
      const float rn = rsqrtf(ss * (1.f / 128.f) + 1e-6f);
#pragma unroll
      for (int d0 = 0; d0 < 8; ++d0) { float x[8];
#pragma unroll
        for (int e = 0; e < 8; ++e) x[e] = bfu(qr[d0][e]) * rn * qgain[d0 * 16 + hi * 8 + e];
        qr[d0] = pack8(x); }
    }
    if (qrope) {
      const int t = t0 + wid * QBLK + r32; const float ri = (float)(t >> 6), ci = (float)(t & 63);
      ROPE_PAIR(0, 4, ri, hi * 8, 32.f); ROPE_PAIR(1, 5, ri, 16 + hi * 8, 32.f); ROPE_PAIR(2, 6, ci, hi * 8, 32.f); ROPE_PAIR(3, 7, ci, 16 + hi * 8, 32.f);
    }
  } else {
    if (qrope) {
      const int t = t0 + wid * QBLK + r32; const float ri = (float)(t >> 6), ci = (float)(t & 63);
      ROPE_PAIR(0, 2, ri, hi * 8, 16.f); ROPE_PAIR(1, 3, ci, hi * 8, 16.f);
    }
  }
  const int sr = tid >> 4, sc = (tid & 15) * 8, vst0 = v_st(sr, sc), vst1 = v_st(32 + sr, sc);
  const int vb0 = (int)(uintptr_t)V_lds + v_rd_base(lane);
  struct { bf16x8 vs0, vs1, ks0, ks1; } sr_[SDEPTH];
#define SLOAD(i, k0) do { sr_[i].vs0 = ld8(&Vh[(long)((k0) + sr) * ldk + sc]); sr_[i].vs1 = ld8(&Vh[(long)((k0) + 32 + sr) * ldk + sc]); \
    sr_[i].ks0 = ld8(&Kh[(long)((k0) + sr) * ldk + sc]); sr_[i].ks1 = ld8(&Kh[(long)((k0) + 32 + sr) * ldk + sc]); } while (0)
#define SWRITE(b, i) do { *(bf16x8*)((char*)V_lds + (b) * SHM_V + vst0) = sr_[i].vs0;          \
    *(bf16x8*)((char*)V_lds + (b) * SHM_V + vst1) = sr_[i].vs1; int kc = sc * 2;               \
    *(bf16x8*)((char*)K_lds + (b) * SHM_K + KSWZ(sr, kc)) = sr_[i].ks0;                       \
    *(bf16x8*)((char*)K_lds + (b) * SHM_K + KSWZ(32 + sr, kc)) = sr_[i].ks1; } while (0)
#define SWAIT() do { if constexpr (SDEPTH == 2) asm volatile("s_waitcnt vmcnt(4)" ::: "memory"); else asm volatile("s_waitcnt vmcnt(0)" ::: "memory"); } while (0)
#define RESC(a) do { if (__any((a) < 1.f)) { if (hi == 0) al_l[r32] = (a); asm volatile("s_waitcnt lgkmcnt(0)" ::: "memory"); \
    _Pragma("unroll") for (int d = 0; d < 4; ++d) _Pragma("unroll") for (int r = 0; r < 16; ++r) o[d][r] *= al_l[crow(r, hi)]; } } while (0)
  f32x16 pA0, pA1, pB0, pB1; float mnA, mnB, alA, alB; bf16x8 pa0, pa1, pa2, pa3; const int NT = seq / KVBLK;
  constexpr int SE = 0, SO = SDEPTH - 1;
  SLOAD(SE, 0); asm volatile("s_waitcnt vmcnt(0)" ::: "memory"); SWRITE(0, SE); __syncthreads();
  qkt<ND>(pA0, pA1, K_lds, qr, r32, hi, kofsB); partialSM(pA0, pA1, m_reg, mnA, alA, C, thr);
  SLOAD(SO, KVBLK); if constexpr (SDEPTH == 2) { if (2 < NT) SLOAD(SE, 2 * KVBLK); }
  SWAIT(); SWRITE(1, SO); __syncthreads();
  for (int j = 1; j + 1 < NT; j += 2) {
    SBAR(); qkt<ND>(pB0, pB1, (bf16*)((char*)K_lds + SHM_K), qr, r32, hi, kofsB);
    finishSM(pA0, pA1, alA, l_reg, pa0, pa1, pa2, pa3); SBAR();
    SLOAD(SO, (j + SDEPTH) * KVBLK); SBAR();
    pv_d0(o, vb0, pa0, pa1, pa2, pa3); partialSM(pB0, pB1, m_reg, mnB, alB, C, thr);
    __syncthreads(); SWAIT(); SWRITE(0, SE);
    RESC(alB); __syncthreads();
    SBAR(); qkt<ND>(pA0, pA1, K_lds, qr, r32, hi, kofsB);
    finishSM(pB0, pB1, alB, l_reg, pa0, pa1, pa2, pa3); SBAR();
    if (SDEPTH == 1 || j + 3 < NT) SLOAD(SE, (j + 1 + SDEPTH) * KVBLK); SBAR();
    pv_d0(o, vb0 + (int)SHM_V, pa0, pa1, pa2, pa3); partialSM(pA0, pA1, m_reg, mnA, alA, C, thr);
    __syncthreads(); SWAIT(); SWRITE(1, SO);
    RESC(alA); __syncthreads();
  }
  SBAR(); qkt<ND>(pB0, pB1, (bf16*)((char*)K_lds + SHM_K), qr, r32, hi, kofsB);
  finishSM(pA0, pA1, alA, l_reg, pa0, pa1, pa2, pa3); SBAR();
  pv_d0(o, vb0, pa0, pa1, pa2, pa3); partialSM(pB0, pB1, m_reg, mnB, alB, C, thr);
  __syncthreads(); RESC(alB);
  finishSM(pB0, pB1, alB, l_reg, pa0, pa1, pa2, pa3); SBAR();
  pv_d0(o, vb0 + (int)SHM_V, pa0, pa1, pa2, pa3);
  if (hi == 0) li_l[r32] = l_reg; asm volatile("s_waitcnt lgkmcnt(0)" ::: "memory");
  float rli[16];
#pragma unroll
  for (int r = 0; r < 16; ++r) rli[r] = __builtin_amdgcn_rcpf(li_l[crow(r, hi)]);
  bf16* Ow = Ob + (long)(wid * QBLK) * ldo;
  if (O1b == nullptr) {
#pragma unroll
    for (int r = 0; r < 16; ++r) { int orow = crow(r, hi);
#pragma unroll
      for (int d0 = 0; d0 < 4; ++d0) Ow[(long)orow * ldo + d0 * 32 + r32] = f2bf_rne(o[d0][r] * rli[r]); }
  } else {
    const bf16* O1w = O1b + (long)(wid * QBLK) * ldo;
    float dg[4];
#pragma unroll
    for (int d0 = 0; d0 < 4; ++d0) dg[d0] = cgain[d0 * 32 + r32] * cscale;
#pragma unroll
    for (int r = 0; r < 16; ++r) { int orow = crow(r, hi); float dv[4]; float ss = 0.f;
#pragma unroll
      for (int d0 = 0; d0 < 4; ++d0) { const float o1 = __builtin_bit_cast(float, (unsigned)O1w[(long)orow * ldo + d0 * 32 + r32] << 16); dv[d0] = o1 - lam * (o[d0][r] * rli[r]); ss += dv[d0] * dv[d0]; }
      ss += __shfl_xor(ss, 1); ss += __shfl_xor(ss, 2); ss += __shfl_xor(ss, 4); ss += __shfl_xor(ss, 8); ss += __shfl_xor(ss, 16);
      const float rn = rsqrtf(ss * (1.f / 128.f) + 1e-6f);
#pragma unroll
      for (int d0 = 0; d0 < 4; ++d0) Ow[(long)orow * ldo + d0 * 32 + r32] = f2bf_rne(dv[d0] * rn * dg[d0]); }
  }
#undef SLOAD
#undef SWRITE
#undef SWAIT
#undef RESC
}
#undef KSWZ
#undef SBAR
#undef ROPE_PAIR
}
constexpr int NWAVES = 8;
constexpr int M = 16384, MCTX = 8192, DM = 2048, NIN = 5376, NINR = 5136, DFF = 8192, NL = 4;
constexpr int C_AQ = 0, C_AK = 1024, C_AV = 1280, C_MQ = 1536, C_MK = 2048, C_MV = 2560, C_MO = 3072, C_DQ = 3584, C_DK = 4096, C_DV = 4608, C_MG = 5120;
constexpr int KVW = 768, LATKV = 4352;
constexpr int NUNIT = 1024;
constexpr int USTR = 129 * 128;
constexpr float EPS = 1e-6f, KSCALE = 0.08838834764831845f;
constexpr size_t O_YP = 0, O_YS = 16777216, O_GK = 33554432, O_GV = 41943040, O_DK = 50331648, O_DV = 67108864, O_MC = 83886080, O_MN = 100663296, O_MM = 100794368, O_END = 100795392;
constexpr size_t MiB = 1u << 20;
constexpr size_t WS_CTL = 0, CTL_ZERO_BYTES = 1 * MiB;
constexpr size_t WS_MOD = 1 * MiB;
constexpr size_t WS_FG = 2 * MiB, WS_SIM = 2 * MiB + 65536, WS_SIN = 3 * MiB;
constexpr size_t WS_W = 4 * MiB, W_LSTRIDE = 93 * MiB, W_IN = 0, W_OUT = 21 * MiB, W_1 = 29 * MiB, W_2 = 61 * MiB;
constexpr size_t WS_HN = 376 * MiB, WS_PROJ = 440 * MiB, WS_KB = 608 * MiB, WS_VB = 633 * MiB, WS_CAT = 658 * MiB, WS_OD = 722 * MiB, WS_MIX = 786 * MiB, WS_H = 850 * MiB;
constexpr size_t WS_US = 1106 * MiB, WS_SIC = 1171 * MiB, WS_GATES = 1203 * MiB, WS_XB = 1204 * MiB, WS_END = 1268 * MiB;
static_assert(WS_W + 4 * W_LSTRIDE <= WS_HN && (size_t)NIN * DM * 2 <= W_OUT && WS_PROJ + (size_t)M * NIN * 2 <= WS_KB && WS_KB + (size_t)(MCTX + 2 * LATKV) * KVW * 2 <= WS_VB &&
              WS_VB + (size_t)(MCTX + 2 * LATKV) * KVW * 2 <= WS_CAT && WS_US + (size_t)NUNIT * USTR * 4 <= WS_SIC && WS_SIC + (size_t)NUNIT * 16384 * 2 <= WS_END, "d_ws map");
constexpr int CW_BAR = 4096, CW_XCC = 8192, CW_GRP = 16384, CW_DEP = 24576;
constexpr int RING_OFF = 0, RING_BYTES = 131072;
constexpr int LDSCTL_OFF = RING_BYTES, MISC_OFF = LDSCTL_OFF + 320;
constexpr int LDS_BYTES = 147456;

#define GAS __attribute__((address_space(1)))
#define LAS __attribute__((address_space(3)))
typedef unsigned short bf16;
typedef unsigned v4u __attribute__((ext_vector_type(4)));
typedef unsigned v2u __attribute__((ext_vector_type(2)));
typedef float f32x4 __attribute__((ext_vector_type(4)));
typedef short bf16x8 __attribute__((ext_vector_type(8)));
typedef GAS unsigned gu32;
#define RLX_AGENT __ATOMIC_RELAXED, __HIP_MEMORY_SCOPE_AGENT
#define LDS_WAIT() asm volatile("s_waitcnt lgkmcnt(0)" ::: "memory")
#define VM_WAIT() asm volatile("s_waitcnt vmcnt(0)" ::: "memory")
__device__ __forceinline__ unsigned f2bf(float f) { unsigned u = __builtin_bit_cast(unsigned, f); return (u + 0x7fffu + ((u >> 16) & 1u)) >> 16; }
__device__ __forceinline__ unsigned pk2(float lo, float hi) { return f2bf(lo) | (f2bf(hi) << 16); }
__device__ __forceinline__ float bf2f(unsigned short b) { return __builtin_bit_cast(float, (unsigned)b << 16); }
__device__ __forceinline__ float bflo(unsigned w) { return __builtin_bit_cast(float, w << 16); }
__device__ __forceinline__ float bfhi(unsigned w) { return __builtin_bit_cast(float, w & 0xffff0000u); }

#define XB_TMO      128
#define XB_XCNT(j)  (256  + 64 * (j))
#define XB_XSUB(j)  (1280 + 64 * (j))
#define XB_XGEN(j)  (2304 + 64 * (j))
#define XB_TOP      3328
#define XB_TOPGEN   3392
#define XCD_BAR_WORDS 3456
#define XB_SPIN_CAP (1u << 22)

__device__ __forceinline__ unsigned xb_ld(unsigned* p)              { return __hip_atomic_load(p, __ATOMIC_RELAXED, __HIP_MEMORY_SCOPE_AGENT); }
__device__ __forceinline__ unsigned xb_add(unsigned* p, unsigned v) { return __hip_atomic_fetch_add(p, v, __ATOMIC_RELAXED, __HIP_MEMORY_SCOPE_AGENT); }
__device__ __forceinline__ unsigned xb_xcc_id() { return (unsigned)__builtin_amdgcn_s_getreg((3 << 11) | 20) & 0xFu; }
#define XB_SPIN(cond, bar) do { unsigned _sp = 0; while (cond) { __builtin_amdgcn_s_sleep(1); \
    if ((++_sp & 255u) == 0u) { if (xb_ld(&(bar)[XB_TMO])) break; if (_sp > XB_SPIN_CAP) { atomicAdd(&(bar)[XB_TMO], 1u); break; } } } } while (0)

struct XcdBarrier {
    unsigned* bar; unsigned x;
    volatile LAS unsigned* st;
};
__device__ __forceinline__ XcdBarrier xcd_barrier_post(unsigned* bar, volatile LAS unsigned* st) {
    XcdBarrier b; b.bar = bar; b.x = xb_xcc_id(); b.st = st;
    if (threadIdx.x == 0) (void)xb_add(&bar[XB_XCNT(b.x)], 1u);
    return b;
}
__device__ __forceinline__ void xcd_barrier_complete(unsigned* bar, unsigned x, unsigned& nloc, unsigned& nx) {
    const unsigned G = gridDim.x * gridDim.y * gridDim.z;
    unsigned sum, cnt, mine, sp = 0u;
    for (;;) {
        sum = 0u; cnt = 0u; mine = 0u;
#pragma unroll
        for (unsigned j = 0; j < 16; ++j) { const unsigned c = xb_ld(&bar[XB_XCNT(j)]); sum += c; cnt += (c > 0u) ? 1u : 0u; mine = (j == x) ? c : mine; }
        if (sum == G) break;
        __builtin_amdgcn_s_sleep(1);
        if ((++sp & 255u) == 0u) { if (xb_ld(&bar[XB_TMO])) break; if (sp > XB_SPIN_CAP) { atomicAdd(&bar[XB_TMO], 1u); break; } }
    }
    nloc = mine > 0u ? mine : 1u; nx = cnt > 0u ? cnt : 1u;
}
__device__ __forceinline__ void xcd_barrier(const XcdBarrier& b) {
    asm volatile("s_waitcnt vmcnt(0)" ::: "memory");
    __syncthreads();
    if (threadIdx.x == 0) {
        unsigned* bar = b.bar;
        __builtin_amdgcn_s_waitcnt(0);
        unsigned nloc = b.st[0], nx = b.st[1];
        if (nloc == 0u) { xcd_barrier_complete(bar, b.x, nloc, nx); b.st[0] = nloc; b.st[1] = nx; }
        const unsigned old = xb_add(&bar[XB_XSUB(b.x)], 1u);
        const unsigned gen = old / nloc;
        if (old + 1u == (gen + 1u) * nloc) {
            __builtin_amdgcn_fence(__ATOMIC_RELEASE, "agent");
            asm volatile("s_waitcnt vmcnt(0)" ::: "memory");
            const unsigned og = xb_add(&bar[XB_TOP], 1u);
            const unsigned tg = og / nx;
            if (og + 1u == (tg + 1u) * nx) xb_add(&bar[XB_TOPGEN], 1u);
            else XB_SPIN(xb_ld(&bar[XB_TOPGEN]) == tg, bar);
            __builtin_amdgcn_fence(__ATOMIC_ACQUIRE, "agent");
            xb_add(&bar[XB_XGEN(b.x)], 1u);
            asm volatile("s_waitcnt vmcnt(0)" ::: "memory");
        } else {
            XB_SPIN(xb_ld(&bar[XB_XGEN(b.x)]) == gen, bar);
            __builtin_amdgcn_fence(__ATOMIC_ACQUIRE, "agent");
            asm volatile("s_waitcnt vmcnt(0)" ::: "memory");
        }
    }
    __syncthreads();
}

__device__ __forceinline__ void grp_barrier(unsigned* ctr, const unsigned target, unsigned* tmo) {
    asm volatile("s_waitcnt vmcnt(0)" ::: "memory");
    __syncthreads();
    if (threadIdx.x == 0) {
        __builtin_amdgcn_s_waitcnt(0);
        (void)xb_add(ctr, 1u);
        unsigned sp = 0;
        while (xb_ld(ctr) < target) { __builtin_amdgcn_s_sleep(1); if ((++sp & 255u) == 0u) { if (xb_ld(tmo)) break; if (sp > XB_SPIN_CAP) { atomicAdd(tmo, 1u); break; } } }
        __builtin_amdgcn_fence(__ATOMIC_ACQUIRE, "agent");
        asm volatile("s_waitcnt vmcnt(0)" ::: "memory");
    }
    __syncthreads();
}

__device__ __forceinline__ void dep_signal(unsigned* ctr) {
    asm volatile("s_waitcnt vmcnt(0)" ::: "memory");
    __syncthreads();
    if (threadIdx.x == 0) { __builtin_amdgcn_s_waitcnt(0); __builtin_amdgcn_fence(__ATOMIC_RELEASE, "agent"); asm volatile("s_waitcnt vmcnt(0)" ::: "memory"); (void)xb_add(ctr, 1u); }
}
__device__ __forceinline__ void dep_wait(unsigned* ctr, const unsigned target, unsigned* tmo) {
    __syncthreads();
    if (threadIdx.x == 0) {
        unsigned sp = 0;
        while (xb_ld(ctr) < target) { __builtin_amdgcn_s_sleep(1); if ((++sp & 255u) == 0u) { if (xb_ld(tmo)) break; if (sp > XB_SPIN_CAP) { atomicAdd(tmo, 1u); break; } } }
        __builtin_amdgcn_fence(__ATOMIC_ACQUIRE, "agent");
        asm volatile("s_waitcnt vmcnt(0)" ::: "memory");
    }
    __syncthreads();
}

struct Args { const float* in[23]; float* out; unsigned char* ws; int limit; int pad; };
struct Frame {
    LAS unsigned char* lds;
    volatile LAS unsigned* MISC;
    gu32* ctl;
    int tid, lane, wave;
    int vcu, G;
    int rbase, rend, rstep;
    int gmode, gtile;
};
typedef const __attribute__((address_space(4))) Args CArgs;
__device__ __forceinline__ CArgs* kargs() { CArgs* p = (CArgs*)__builtin_amdgcn_kernarg_segment_ptr(); asm volatile("" : "+s"(p)); return p; }
__device__ __forceinline__ bf16* wptr(CArgs& A, int l, size_t off) { return (bf16*)(A.ws + WS_W + (size_t)l * W_LSTRIDE + off); }

__device__ __forceinline__ float wave_sum(float v) {
#pragma unroll
    for (int o = 1; o < 64; o <<= 1) v += __shfl_xor(v, o);
    return v;
}
#define MFMA16(a, b, c) __builtin_amdgcn_mfma_f32_16x16x32_bf16((a), (b), (c), 0, 0, 0)

__device__ __forceinline__ void transpose_item(const float* W, int ldw, int c0, int nblk, int K, bf16* WT, int row_off, LAS float* scr, int item, int lane) {
    const int kb = item / nblk, nb = item % nblk, k0 = 64 * kb, n0 = 32 * nb;
    { f32x4 wv_[8]; const int c4 = lane & 7;
#pragma unroll
      for (int i = 0; i < 8; ++i) { const int kk = 8 * i + (lane >> 3); wv_[i] = *(const GAS f32x4*)(W + (size_t)(k0 + kk) * ldw + c0 + n0 + c4 * 4); }
      __builtin_amdgcn_sched_barrier(0);
#pragma unroll
      for (int i = 0; i < 8; ++i) { const int kk = 8 * i + (lane >> 3); LAS float* d = scr + kk * 33 + c4 * 4; d[0] = wv_[i].x; d[1] = wv_[i].y; d[2] = wv_[i].z; d[3] = wv_[i].w; } }
    LDS_WAIT(); asm volatile("" ::: "memory");
    const int c = lane & 7;
#pragma unroll
    for (int j = 0; j < 4; ++j) { const int n = (lane >> 3) + 8 * j; const LAS float* s = scr + (8 * c) * 33 + n;
        v4u o; o.x = pk2(s[0 * 33], s[1 * 33]); o.y = pk2(s[2 * 33], s[3 * 33]); o.z = pk2(s[4 * 33], s[5 * 33]); o.w = pk2(s[6 * 33], s[7 * 33]);
        *(GAS v4u*)(WT + (size_t)(row_off + n0 + n) * K + k0 + 8 * c) = o; }
    LDS_WAIT(); asm volatile("" ::: "memory");
}
__device__ __forceinline__ void p0_prologue(CArgs& A, Frame& F) {
    LAS float* scr = (LAS float*)(F.lds + RING_OFF + F.wave * 8448);
    LAS float* SIL = (LAS float*)(F.lds + RING_OFF + 81920);
    for (int i = F.tid; i < 3 * DM; i += NWAVES * 64) { const int c = i >> 11, k = i & 2047; const float v = (c == 0) ? A.in[10][k] : A.in[2][(c - 1) * DM + k]; SIL[i] = v / (1.f + expf(-v)); }
    __syncthreads();
    { LAS float* PART = (LAS float*)(F.lds + RING_OFF + 106496);
      for (int item = F.vcu; item < NL * 48; item += F.G) {
          const int l = item / 48, jb = item % 48, kb = F.wave * 256;
          const float* Wp = A.in[11] + (size_t)l * DM * 12288 + (size_t)kb * 12288 + jb * 256 + F.lane * 4;
          f32x4 a0 = (f32x4){0.f, 0.f, 0.f, 0.f}, a1 = a0, a2 = a0;
          for (int k0 = 0; k0 < 256; k0 += 16) { f32x4 wv_[16];
#pragma unroll
              for (int k = 0; k < 16; ++k) wv_[k] = *(const GAS f32x4*)(Wp + (size_t)(k0 + k) * 12288);
              __builtin_amdgcn_sched_barrier(0);
#pragma unroll
              for (int k = 0; k < 16; ++k) { a0 = a0 + wv_[k] * SIL[kb + k0 + k]; a1 = a1 + wv_[k] * SIL[DM + kb + k0 + k]; a2 = a2 + wv_[k] * SIL[2 * DM + kb + k0 + k]; } }
          *(LAS f32x4*)(PART + (F.wave * 3 + 0) * 256 + F.lane * 4) = a0; *(LAS f32x4*)(PART + (F.wave * 3 + 1) * 256 + F.lane * 4) = a1; *(LAS f32x4*)(PART + (F.wave * 3 + 2) * 256 + F.lane * 4) = a2;
          __syncthreads();
          if (F.wave < 3) { f32x4 sum = *(const GAS f32x4*)(A.in[12] + l * 12288 + jb * 256 + F.lane * 4);
#pragma unroll
              for (int w2 = 0; w2 < 8; ++w2) sum = sum + *(const LAS f32x4*)(PART + (w2 * 3 + F.wave) * 256 + F.lane * 4);
              *(GAS f32x4*)(((float*)(A.ws + WS_MOD)) + (size_t)(l * 3 + F.wave) * 12288 + jb * 256 + F.lane * 4) = sum; }
          __syncthreads();
      } }
    const int gw = F.vcu * NWAVES + F.wave, NGW = F.G * NWAVES;
    constexpr int I_A = 32 * 112, I_B = 32 * 48, I_O = 32 * 64, I_1 = 32 * 256, I_2 = 128 * 64, I_L = I_A + I_B + I_O + I_1 + I_2;
    for (int it = gw; it < NL * I_L; it += NGW) {
        const int l = it / I_L; int r = it % I_L;
        const float* win = A.in[14] + (size_t)l * DM * NINR;
        if (r < I_A) { transpose_item(win, NINR, 0, 112, DM, wptr(A, l, W_IN), 0, scr, r, F.lane); continue; } r -= I_A;
        if (r < I_B) { transpose_item(win, NINR, 3600, 48, DM, wptr(A, l, W_IN), 3584, scr, r, F.lane); continue; } r -= I_B;
        if (r < I_O) { transpose_item(A.in[15] + (size_t)l * DM * DM, DM, 0, 64, DM, wptr(A, l, W_OUT), 0, scr, r, F.lane); continue; } r -= I_O;
        if (r < I_1) { transpose_item(A.in[21] + (size_t)l * DM * DFF, DFF, 0, 256, DM, wptr(A, l, W_1), 0, scr, r, F.lane); continue; } r -= I_1;
        transpose_item(A.in[22] + (size_t)l * DFF * DM, DM, 0, 64, DFF, wptr(A, l, W_2), 0, scr, r, F.lane);
    }
    const int gt = F.vcu * NWAVES * 64 + F.tid, NT = F.G * NWAVES * 64;
    for (int it = gt; it < NL * 16 * 256; it += NT) {
        const int l = it >> 12, r = (it >> 8) & 15, k8 = (it & 255) * 8;
        v4u o = {0u, 0u, 0u, 0u};
        { const float* s = A.in[14] + (size_t)l * DM * NINR + (size_t)k8 * NINR + 3584 + r;
            o.x = pk2(s[0], s[NINR]); o.y = pk2(s[2 * NINR], s[3 * NINR]); o.z = pk2(s[4 * NINR], s[5 * NINR]); o.w = pk2(s[6 * NINR], s[7 * NINR]); }
        *(GAS v4u*)(wptr(A, l, W_IN) + (size_t)(C_MG + r) * DM + k8) = o;
    }
}

__device__ __forceinline__ void row_phase(CArgs& A, Frame& F, const bf16* y, const float* gA, const float* gate, const int xin, const int xout, const bool write_hn, const float* gB, const float* sc, const float* sh) {
    const int lane = F.lane;
    if (F.gmode) {
        const int row_b = F.rbase + F.wave * 8;
        const int cond = row_b < MCTX ? 0 : 1 + ((row_b - MCTX) >> 12);
        f32x4 gav[8], gtv[8], gs[8], shv[8];
        if (y) { const GAS f32x4* ga = (const GAS f32x4*)gA + lane; const GAS f32x4* gt = (const GAS f32x4*)(gate + (size_t)cond * 12288) + lane;
#pragma unroll
            for (int j = 0; j < 8; ++j) { gav[j] = ga[64 * j]; gtv[j] = gt[64 * j]; } }
        if (write_hn) { const GAS f32x4* gb = (const GAS f32x4*)gB + lane; const GAS f32x4* scp = (const GAS f32x4*)(sc + (size_t)cond * 12288) + lane; const GAS f32x4* shp = (const GAS f32x4*)(sh + (size_t)cond * 12288) + lane;
#pragma unroll
            for (int j = 0; j < 8; ++j) { gs[j] = gb[64 * j] * (scp[64 * j] + 1.f); shv[j] = shp[64 * j]; } }
        for (int row = row_b; row < row_b + 8; ++row) {
            f32x4 x[8]; v2u xb[8], yb[8];
            if (xin == 0) { const float* xr = (row < MCTX) ? A.in[0] + (size_t)row * DM : A.in[1] + (size_t)(row - MCTX) * DM;
#pragma unroll
                for (int j = 0; j < 8; ++j) x[j] = ((const GAS f32x4*)xr)[lane + 64 * j]; }
            else { const GAS v2u* xr = (const GAS v2u*)(((bf16*)(A.ws + WS_XB)) + (size_t)row * DM) + lane;
#pragma unroll
                for (int j = 0; j < 8; ++j) xb[j] = xr[64 * j]; }
            if (y) { const GAS v2u* yr = (const GAS v2u*)(y + (size_t)row * DM) + lane;
#pragma unroll
                for (int j = 0; j < 8; ++j) yb[j] = yr[64 * j]; }
            __builtin_amdgcn_sched_barrier(0);
            if (xin != 0) {
#pragma unroll
                for (int j = 0; j < 8; ++j) x[j] = (f32x4){bflo(xb[j].x), bfhi(xb[j].x), bflo(xb[j].y), bfhi(xb[j].y)}; }
            if (y) {
                f32x4 yv[8]; float ss = 0.f;
#pragma unroll
                for (int j = 0; j < 8; ++j) { const v2u w = yb[j]; yv[j] = (f32x4){bflo(w.x), bfhi(w.x), bflo(w.y), bfhi(w.y)}; ss += (yv[j].x * yv[j].x + yv[j].y * yv[j].y) + (yv[j].z * yv[j].z + yv[j].w * yv[j].w); }
                const float r = rsqrtf(wave_sum(ss) * (1.f / DM) + EPS);
#pragma unroll
                for (int j = 0; j < 8; ++j) x[j] = x[j] + gtv[j] * (yv[j] * r * gav[j]);
                if (xout) { GAS f32x4* xo = (GAS f32x4*)(A.out + (size_t)row * DM) + lane;
#pragma unroll
                    for (int j = 0; j < 8; ++j) xo[64 * j] = x[j]; }
                else { GAS v2u* xo = (GAS v2u*)(((bf16*)(A.ws + WS_XB)) + (size_t)row * DM) + lane;
#pragma unroll
                    for (int j = 0; j < 8; ++j) { v2u w; w.x = pk2(x[j].x, x[j].y); w.y = pk2(x[j].z, x[j].w); xo[64 * j] = w; } }
            }
            if (write_hn) {
                float ss = 0.f;
#pragma unroll
                for (int j = 0; j < 8; ++j) ss += (x[j].x * x[j].x + x[j].y * x[j].y) + (x[j].z * x[j].z + x[j].w * x[j].w);
                const float r = rsqrtf(wave_sum(ss) * (1.f / DM) + EPS);
                GAS v2u* ho = (GAS v2u*)(((bf16*)(A.ws + WS_HN)) + (size_t)row * DM) + lane;
#pragma unroll
                for (int j = 0; j < 8; ++j) { const f32x4 h = (x[j] * r) * gs[j] + shv[j]; v2u w; w.x = pk2(h.x, h.y); w.y = pk2(h.z, h.w); ho[64 * j] = w; }
            }
        }
        return;
    }
    for (int row = F.rbase + F.wave; row < F.rend; row += F.rstep) {
        const int cond = row < MCTX ? 0 : 1 + ((row - MCTX) >> 12);
        f32x4 x[8];
        v2u xb[8], yb[8]; f32x4 gav[8], gtv[8];
        if (xin == 0) { const float* xr = (row < MCTX) ? A.in[0] + (size_t)row * DM : A.in[1] + (size_t)(row - MCTX) * DM;
#pragma unroll
            for (int j = 0; j < 8; ++j) x[j] = ((const GAS f32x4*)xr)[lane + 64 * j]; }
        else { const GAS v2u* xr = (const GAS v2u*)(((bf16*)(A.ws + WS_XB)) + (size_t)row * DM) + lane;
#pragma unroll
            for (int j = 0; j < 8; ++j) xb[j] = xr[64 * j]; }
        if (y) { const GAS v2u* yr = (const GAS v2u*)(y + (size_t)row * DM) + lane; const GAS f32x4* ga = (const GAS f32x4*)gA + lane; const GAS f32x4* gt = (const GAS f32x4*)(gate + (size_t)cond * 12288) + lane;
#pragma unroll
            for (int j = 0; j < 8; ++j) yb[j] = yr[64 * j];
#pragma unroll
            for (int j = 0; j < 8; ++j) { gav[j] = ga[64 * j]; gtv[j] = gt[64 * j]; } }
        __builtin_amdgcn_sched_barrier(0);
        if (xin != 0) {
#pragma unroll
            for (int j = 0; j < 8; ++j) x[j] = (f32x4){bflo(xb[j].x), bfhi(xb[j].x), bflo(xb[j].y), bfhi(xb[j].y)}; }
        if (y) {
            f32x4 yv[8]; float ss = 0.f;
#pragma unroll
            for (int j = 0; j < 8; ++j) { const v2u w = yb[j]; yv[j] = (f32x4){bflo(w.x), bfhi(w.x), bflo(w.y), bfhi(w.y)}; ss += (yv[j].x * yv[j].x + yv[j].y * yv[j].y) + (yv[j].z * yv[j].z + yv[j].w * yv[j].w); }
            const float r = rsqrtf(wave_sum(ss) * (1.f / DM) + EPS);
#pragma unroll
            for (int j = 0; j < 8; ++j) x[j] = x[j] + gtv[j] * (yv[j] * r * gav[j]);
            if (xout) { GAS f32x4* xo = (GAS f32x4*)(A.out + (size_t)row * DM) + lane;
#pragma unroll
                for (int j = 0; j < 8; ++j) xo[64 * j] = x[j]; }
            else { GAS v2u* xo = (GAS v2u*)(((bf16*)(A.ws + WS_XB)) + (size_t)row * DM) + lane;
#pragma unroll
                for (int j = 0; j < 8; ++j) { v2u w; w.x = pk2(x[j].x, x[j].y); w.y = pk2(x[j].z, x[j].w); xo[64 * j] = w; } }
        }
        if (write_hn) {
            const GAS f32x4* gb = (const GAS f32x4*)gB + lane; const GAS f32x4* scp = (const GAS f32x4*)(sc + (size_t)cond * 12288) + lane; const GAS f32x4* shp = (const GAS f32x4*)(sh + (size_t)cond * 12288) + lane;
            f32x4 gbv[8], scv[8], shv[8];
#pragma unroll
            for (int j = 0; j < 8; ++j) { gbv[j] = gb[64 * j]; scv[j] = scp[64 * j]; shv[j] = shp[64 * j]; }
            __builtin_amdgcn_sched_barrier(0);
            float ss = 0.f;
#pragma unroll
            for (int j = 0; j < 8; ++j) ss += (x[j].x * x[j].x + x[j].y * x[j].y) + (x[j].z * x[j].z + x[j].w * x[j].w);
            const float r = rsqrtf(wave_sum(ss) * (1.f / DM) + EPS);
            GAS v2u* ho = (GAS v2u*)(((bf16*)(A.ws + WS_HN)) + (size_t)row * DM) + lane;
#pragma unroll
            for (int j = 0; j < 8; ++j) { const f32x4 h = (x[j] * r * gbv[j]) * (scv[j] + 1.f) + shv[j]; v2u w; w.x = pk2(h.x, h.y); w.y = pk2(h.z, h.w); ho[64 * j] = w; }
        }
    }
}

__device__ __forceinline__ void unpack8(const v4u w, float* x) { x[0] = bflo(w.x); x[1] = bfhi(w.x); x[2] = bflo(w.y); x[3] = bfhi(w.y); x[4] = bflo(w.z); x[5] = bfhi(w.z); x[6] = bflo(w.w); x[7] = bfhi(w.w); }
__device__ __forceinline__ v4u packv8(const float* x) { v4u w; w.x = pk2(x[0], x[1]); w.y = pk2(x[2], x[3]); w.z = pk2(x[4], x[5]); w.w = pk2(x[6], x[7]); return w; }
__device__ __forceinline__ void store8f(float* o, const float* x) { *(GAS f32x4*)o = (f32x4){x[0], x[1], x[2], x[3]}; *(GAS f32x4*)(o + 4) = (f32x4){x[4], x[5], x[6], x[7]}; }
__device__ __forceinline__ void gates_part(CArgs& A, Frame& F, const int l) {
    const int gw = F.vcu * NWAVES + F.wave, NGW = F.G * NWAVES, lane = F.lane;
    { LAS unsigned char* wl = F.lds + RING_OFF; const GAS v4u* wgsrc = (const GAS v4u*)(wptr(A, l, W_IN) + (size_t)C_MG * DM);
      __syncthreads();
      const int fr = lane & 15, fq = lane >> 4;
      if (F.gmode) {
          const int it = F.gtile + (F.wave & 3), kh = F.wave >> 2;
          const bf16* hp = ((bf16*)(A.ws + WS_HN)) + (size_t)(it * 16 + fr) * DM + kh * 1024 + fq * 8;
          bf16x8 av[32];
#pragma unroll
          for (int k = 0; k < 32; ++k) av[k] = *(const bf16x8*)(hp + k * 32);
          __builtin_amdgcn_sched_barrier(0);
          { v4u wv[8];
#pragma unroll
            for (int q = 0; q < 8; ++q) wv[q] = wgsrc[F.tid + q * (NWAVES * 64)];
            __builtin_amdgcn_sched_barrier(0);
#pragma unroll
            for (int q = 0; q < 8; ++q) { const int i = F.tid + q * (NWAVES * 64); *(LAS v4u*)(wl + (i >> 8) * 4112 + (i & 255) * 16) = wv[q]; } }
          __syncthreads();
          const LAS unsigned char* wp = wl + fr * 4112 + kh * 2048 + fq * 16;
          f32x4 acc = (f32x4){0.f, 0.f, 0.f, 0.f};
#pragma unroll
          for (int k = 0; k < 32; ++k) { const bf16x8 bv = *(const LAS bf16x8*)(wp + k * 64); acc = MFMA16(av[k], bv, acc); }
          LAS f32x4* part = (LAS f32x4*)(wl + 66048) + (F.wave & 3) * 64 + lane;
          if (kh == 1) *part = acc;
          __syncthreads();
          if (kh == 0) { acc = acc + *part;
              float* go = ((float*)(A.ws + WS_GATES)) + (size_t)(it * 16 + fq * 4) * 16 + fr;
#pragma unroll
              for (int r = 0; r < 4; ++r) go[r * 16] = acc[r]; }
          return;
      }
      for (int i = F.tid; i < 16 * DM / 8; i += NWAVES * 64) *(LAS v4u*)(wl + (i >> 8) * 4112 + (i & 255) * 16) = wgsrc[i];
      __syncthreads();
      for (int it = F.vcu + F.G * F.wave; it < M / 16; it += NGW) {
          const bf16* hp = ((bf16*)(A.ws + WS_HN)) + (size_t)(it * 16 + fr) * DM + fq * 8;
          const LAS unsigned char* wp = wl + fr * 4112 + fq * 16;
          f32x4 acc = (f32x4){0.f, 0.f, 0.f, 0.f};
          for (int k0 = 0; k0 < 64; k0 += 16) { bf16x8 av[16];
#pragma unroll
              for (int k = 0; k < 16; ++k) av[k] = *(const bf16x8*)(hp + (k0 + k) * 32);
              __builtin_amdgcn_sched_barrier(0);
#pragma unroll
              for (int k = 0; k < 16; ++k) { const bf16x8 bv = *(const LAS bf16x8*)(wp + (k0 + k) * 64); acc = MFMA16(av[k], bv, acc); } }
          float* go = ((float*)(A.ws + WS_GATES)) + (size_t)(it * 16 + fq * 4) * 16 + fr;
#pragma unroll
          for (int r = 0; r < 4; ++r) go[r * 16] = acc[r];
      } }
}
__device__ __forceinline__ void p2_postproj(CArgs& A, Frame& F, const int l) {
    const int gw = F.vcu * NWAVES + F.wave, NGW = F.G * NWAVES, lane = F.lane, c16 = lane & 15;
    const float L2T = 13.287712379549449f;
    float g1v[8], inv128[8], inv64[8];
#pragma unroll
    for (int e = 0; e < 8; ++e) { g1v[e] = A.in[16][l * 256 + 128 + c16 * 8 + e];
        inv128[e] = exp2f(-(float)((lane & 3) * 8 + e) * (L2T / 32.f)); inv64[e] = exp2f(-(float)((lane & 1) * 8 + e) * (L2T / 16.f)); }
    v4u n1 = {0u, 0u, 0u, 0u}, n2 = n1, n3 = n1;
    if (gw < M) { const bf16* pr0 = ((bf16*)(A.ws + WS_PROJ)) + (size_t)gw * NIN; n1 = *(const GAS v4u*)(pr0 + C_AK + lane * 8); n2 = *(const GAS v4u*)(pr0 + C_DK + lane * 8); n3 = *(const GAS v4u*)(pr0 + C_DV + lane * 8); }
    for (int row = gw; row < M; row += NGW) {
        const bool lat = row >= MCTX;
        float ri = 0.f, ci = 0.f; int krow, b, t;
        if (lat) { const int rr = row - MCTX; b = rr >> 12; t = rr & 4095; ri = (float)(t >> 6); ci = (float)(t & 63); krow = MCTX + b * LATKV + t; }
        else { b = row >> 8; t = row & 255; krow = row; }
        bf16* kb = ((bf16*)(A.ws + WS_KB)) + (size_t)krow * KVW; bf16* vb = ((bf16*)(A.ws + WS_VB)) + (size_t)krow * KVW;
        const size_t ob = (size_t)(b * NL + l) * 256 + t;
        const v4u w1 = n1, w2 = n2, w3 = n3;
        if (row + NGW < M) { const bf16* pn = ((bf16*)(A.ws + WS_PROJ)) + (size_t)(row + NGW) * NIN;
            n1 = *(const GAS v4u*)(pn + C_AK + lane * 8); n2 = *(const GAS v4u*)(pn + C_DK + lane * 8); n3 = *(const GAS v4u*)(pn + C_DV + lane * 8); }
        __builtin_amdgcn_sched_barrier(0);
        float x[8];
        unpack8(w1, x);
        { float ss = 0.f;
#pragma unroll
          for (int e = 0; e < 8; ++e) ss += x[e] * x[e];
          ss += __shfl_xor(ss, 1); ss += __shfl_xor(ss, 2); ss += __shfl_xor(ss, 4); ss += __shfl_xor(ss, 8);
          const float rn = rsqrtf(ss * (1.f / 128.f) + EPS);
          float kx[8];
#pragma unroll
          for (int e = 0; e < 8; ++e) kx[e] = x[e] * rn * g1v[e];
          if (lat) { const float pos = ((lane & 7) < 4) ? ri : ci;
#pragma unroll
              for (int e = 0; e < 8; ++e) { const float ang = pos * inv128[e], c = __cosf(ang), s = __sinf(ang); const float oth = __shfl_xor(kx[e], 8);
                  kx[e] = (c16 < 8) ? kx[e] * c - oth * s : oth * s + kx[e] * c; } }
          if (lane < 32) { *(GAS v4u*)(kb + lane * 8) = packv8(kx); if (!lat) store8f(A.out + O_GK + ob * 256 + lane * 8, kx); }
          else { *(GAS v4u*)(vb + (lane - 32) * 8) = w1; if (!lat) store8f(A.out + O_GV + ob * 256 + (lane - 32) * 8, x); } }
        unpack8(w2, x);
        if (lat) { const float pos = ((lane & 3) < 2) ? ri : ci;
#pragma unroll
            for (int e = 0; e < 8; ++e) { const float ang = pos * inv64[e], c = __cosf(ang), s = __sinf(ang); const float oth = __shfl_xor(x[e], 4);
                x[e] = ((lane & 7) < 4) ? x[e] * c - oth * s : oth * s + x[e] * c; }
            *(GAS v4u*)(kb + 256 + lane * 8) = packv8(x); }
        else { *(GAS v4u*)(kb + 256 + lane * 8) = w2; store8f(A.out + O_DK + ob * 512 + lane * 8, x); }
        *(GAS v4u*)(vb + 256 + lane * 8) = w3;
        if (!lat) { unpack8(w3, x); store8f(A.out + O_DV + ob * 512 + lane * 8, x); }
    }
    for (int base = gw; base < 512 * 24; base += 6 * NGW) { float cv[6];
#pragma unroll
      for (int k = 0; k < 6; ++k) { const int it = base + k * NGW; const int rowi = it / 24, j = it % 24; const int b = rowi >> 8, p = rowi & 255;
          const size_t cg = ((size_t)(b * NL + l) * 256 + p) * 256, cd = ((size_t)(b * NL + l) * 256 + p) * 512;
          const float* src = (j < 4) ? A.in[3] + cg + j * 64 : (j < 8) ? A.in[4] + cg + (j - 4) * 64 : (j < 16) ? A.in[5] + cd + (j - 8) * 64 : A.in[6] + cd + (j - 16) * 64;
          cv[k] = (it < 512 * 24) ? src[lane] : 0.f; }
      __builtin_amdgcn_sched_barrier(0);
#pragma unroll
      for (int k = 0; k < 6; ++k) { const int it = base + k * NGW; const int rowi = it / 24, j = it % 24; const int b = rowi >> 8, p = rowi & 255; const size_t krow = (size_t)MCTX + b * LATKV + 4096 + p;
          bf16* kb = ((bf16*)(A.ws + WS_KB)) + krow * KVW; bf16* vb = ((bf16*)(A.ws + WS_VB)) + krow * KVW;
          bf16* dst = (j < 4) ? kb + j * 64 : (j < 8) ? vb + (j - 4) * 64 : (j < 16) ? kb + 256 + (j - 8) * 64 : vb + 256 + (j - 16) * 64;
          if (it < 512 * 24) dst[lane] = (bf16)f2bf(cv[k]); } }
}

__device__ __forceinline__ void wave_scan_add2(const float a, const float b, const int lane, float& ia, float& ib) {
    float s = a + b;
#pragma unroll
    for (int o = 1; o < 64; o <<= 1) { const float t = __shfl_up(s, o); if (lane >= o) s += t; }
    ia = (s - (a + b)) + a; ib = s;
}
__device__ __forceinline__ void wave_scan_max2(const float a, const float b, const int lane, float& ia, float& ib) {
    float s = fmaxf(a, b);
#pragma unroll
    for (int o = 1; o < 64; o <<= 1) { const float t = __shfl_up(s, o); if (lane >= o) s = fmaxf(s, t); }
    const float prev = __shfl_up(s, 1); ia = (lane >= 1) ? fmaxf(prev, a) : a; ib = s;
}
__device__ __forceinline__ float wave_max(float v) {
#pragma unroll
    for (int o = 1; o < 64; o <<= 1) v = fmaxf(v, __shfl_xor(v, o));
    return v;
}
__device__ __forceinline__ float logsigf(float x) { return fminf(x, 0.f) - log1pf(expf(-fabsf(x))); }

__device__ __forceinline__ unsigned dui_off_b(unsigned row, unsigned ch) { return 256u * row + 16u * (ch ^ (((row & 3) << 2) | ((row >> 2) & 3))); }
__device__ __forceinline__ unsigned tr16_addr(unsigned lane, unsigned c, unsigned t) { const unsigned g = lane >> 4, q = (lane & 15) >> 2, p = lane & 3; return dui_off_b(8 * g + 4 * t + q, 2 * c + (p >> 1)) + 8 * (p & 1); }
typedef short s16x4v __attribute__((ext_vector_type(4)));
template <int OFF> __device__ __forceinline__ s16x4v tr16_read(unsigned addr) { s16x4v r; asm volatile("ds_read_b64_tr_b16 %0, %1 offset:%2" : "=&v"(r) : "v"(addr), "i"(OFF) : "memory"); return r; }
#define TR_PK(L, H) (bf16x8){L[0], L[1], L[2], L[3], H[0], H[1], H[2], H[3]}

__device__ __forceinline__ void p3_summary_units(CArgs& A, Frame& F, const int l, const int nrep) {
    const int tid = F.tid, lane = F.lane, w = F.wave, fr = lane & 15, fq = lane >> 4;
    LAS unsigned char* KWI = F.lds + RING_OFF;
    const int s0 = tid >> 4, ch = tid & 15;
    bf16x8 kvv[4], vvv[4]; float gi0 = 0.f, gf0 = 0.f, gi1 = 0.f, gf1 = 0.f;
#define P3_LOAD(U) do { const int dir_ = (U) & 1, h_ = ((U) >> 1) & 3, row0_ = ((U) >> 3) * 128; \
        _Pragma("unroll") for (int i = 0; i < 4; ++i) { const int s = s0 + 32 * i; \
            kvv[i] = *(const bf16x8*)(((bf16*)(A.ws + WS_PROJ)) + (size_t)(row0_ + s) * NIN + C_MK + h_ * 128 + ch * 8); vvv[i] = *(const bf16x8*)(((bf16*)(A.ws + WS_PROJ)) + (size_t)(row0_ + s) * NIN + C_MV + h_ * 128 + ch * 8); } \
        const float* pr = ((const float*)(A.ws + WS_GATES)) + (size_t)(row0_ + 2 * lane) * 16 + dir_ * 8 + h_; gi0 = pr[0]; gf0 = pr[4]; gi1 = pr[16]; gf1 = pr[20]; } while (0)
    const int nun = NUNIT * nrep;
    if (F.vcu < nun) P3_LOAD(F.vcu % NUNIT);
  for (int un = F.vcu; un < nun; un += F.G) {
    const int unit = un % NUNIT;
    const int dir = unit & 1, h = (unit >> 1) & 3;
    __builtin_amdgcn_sched_barrier(0);
    float wsv[4];
    { const float bi = A.in[17][((l * 2 + dir) * 2 + 0) * 4 + h], bfo = A.in[17][((l * 2 + dir) * 2 + 1) * 4 + h];
      const float ig0 = gi0 + bi, ig1 = gi1 + bi, l0 = logsigf(gf0 + bfo), l1 = logsigf(gf1 + bfo);
      float i0, i1; wave_scan_add2(l0, l1, lane, i0, i1);
      const float run = __shfl(i1, 63);
      const float a0 = (dir == 0) ? (run - i0) + ig0 : (i0 - l0) + ig0, a1 = (dir == 0) ? (run - i1) + ig1 : (i1 - l1) + ig1;
      const float G = wave_max(fmaxf(a0, a1));
      const float w0 = __expf(a0 - G) * KSCALE, w1 = __expf(a1 - G) * KSCALE;
      if (w == 0 && lane == 0) { ((float*)(A.ws + WS_FG))[unit * 2] = run; ((float*)(A.ws + WS_FG))[unit * 2 + 1] = G; }
#pragma unroll
      for (int i = 0; i < 4; ++i) { const int s = s0 + 32 * i; const float v0 = __shfl(w0, s >> 1), v1 = __shfl(w1, s >> 1); wsv[i] = (s & 1) ? v1 : v0; } }
    __syncthreads();
#pragma unroll
    for (int i = 0; i < 4; ++i) { const int s = s0 + 32 * i; float x[8];
#pragma unroll
        for (int e = 0; e < 8; ++e) x[e] = bf2f((unsigned short)kvv[i][e]) * wsv[i];
        const unsigned o = (unsigned)(s >> 5) * 8192u + dui_off_b((unsigned)(s & 31), (unsigned)ch);
        *(LAS v4u*)(KWI + o) = packv8(x); *(LAS bf16x8*)(KWI + 32768 + o) = vvv[i]; }
    __syncthreads();
    if (un + F.G < nun) P3_LOAD((un + F.G) % NUNIT);
    __builtin_amdgcn_sched_barrier(0);
    unsigned ta[8][2];
#pragma unroll
    for (int c = 0; c < 8; ++c) { ta[c][0] = (unsigned)(uintptr_t)KWI + tr16_addr((unsigned)lane, (unsigned)c, 0u); ta[c][1] = (unsigned)(uintptr_t)KWI + tr16_addr((unsigned)lane, (unsigned)c, 1u); }
    unsigned taw0 = ta[0][0], taw1 = ta[0][1];
#pragma unroll
    for (int c = 1; c < 8; ++c) { if (w == c) { taw0 = ta[c][0]; taw1 = ta[c][1]; } }
    f32x4 acc[9];
#pragma unroll
    for (int et = 0; et < 9; ++et) acc[et] = (f32x4){0.f, 0.f, 0.f, 0.f};
    const bf16x8 ones = (fr == 0) ? (bf16x8){0x3F80, 0x3F80, 0x3F80, 0x3F80, 0x3F80, 0x3F80, 0x3F80, 0x3F80} : (bf16x8){0, 0, 0, 0, 0, 0, 0, 0};
#define P3_KSTEP(KS) do { \
        const s16x4v al = tr16_read<(KS) * 8192>(taw0), ah = tr16_read<(KS) * 8192>(taw1); \
        s16x4v bl[8], bh[8]; \
        _Pragma("unroll") for (int c = 0; c < 8; ++c) { bl[c] = tr16_read<32768 + (KS) * 8192>(ta[c][0]); bh[c] = tr16_read<32768 + (KS) * 8192>(ta[c][1]); } \
        asm volatile("s_waitcnt lgkmcnt(0)" ::: "memory"); __builtin_amdgcn_sched_barrier(0); \
        const bf16x8 af = TR_PK(al, ah); \
        _Pragma("unroll") for (int c = 0; c < 8; ++c) acc[c] = MFMA16(af, TR_PK(bl[c], bh[c]), acc[c]); \
        acc[8] = MFMA16(af, ones, acc[8]); } while (0)
    P3_KSTEP(0); P3_KSTEP(1); P3_KSTEP(2); P3_KSTEP(3);
#undef P3_KSTEP
    float* uo = ((float*)(A.ws + WS_US)) + (size_t)unit * USTR;
    if (fr == 0) {
#pragma unroll
        for (int r = 0; r < 4; ++r) uo[16384 + 16 * w + fq * 4 + r] = acc[8][r]; }
#pragma unroll
    for (int et = 0; et < 8; ++et)
#pragma unroll
        for (int r = 0; r < 4; ++r) uo[(16 * w + fq * 4 + r) * 128 + 16 * et + fr] = acc[et][r];
  }
#undef P3_LOAD
}

constexpr int QSTR = USTR / 4;
__device__ __forceinline__ v2u pack4bf(const f32x4 v) { v2u w; w.x = pk2(v.x, v.y); w.y = pk2(v.z, v.w); return w; }
__device__ __forceinline__ void p4_scan(CArgs& A, Frame& F, const int l) {
    const int gt = F.vcu * NWAVES * 64 + F.tid, NT = F.G * NWAVES * 64;
    const float* US = (const float*)(A.ws + WS_US); const float* FG = (const float*)(A.ws + WS_FG);
    bf16* SIC = (bf16*)(A.ws + WS_SIC); float* SIN = (float*)(A.ws + WS_SIN); float* SIM = (float*)(A.ws + WS_SIM);
    for (int it = gt; it < 16 * QSTR; it += NT) {
        const int chain = it / QSTR, el = (it % QSTR) * 4; const int b = chain >> 3, h = (chain >> 1) & 3, dir = chain & 1, cg0 = 64 + 32 * b;
        const size_t si = (size_t)((b * NL + l) * 2 + dir) * 4 + h;
        f32x4 val = (el < 16384) ? *(const GAS f32x4*)(A.in[7] + si * 16384 + el) : *(const GAS f32x4*)(A.in[8] + si * 128 + (el - 16384)); float m = A.in[9][si];
        for (int hb = 0; hb < 4; ++hb) {
            f32x4 uv[8]; float fv[8], gv[8];
#pragma unroll
            for (int i = 0; i < 8; ++i) { const int st = hb * 8 + i, cg = (dir == 0) ? cg0 + st : cg0 + 31 - st; const int unit = (cg * 4 + h) * 2 + dir;
                uv[i] = *(const GAS f32x4*)(US + (size_t)unit * USTR + el); fv[i] = FG[unit * 2]; gv[i] = FG[unit * 2 + 1]; }
            __builtin_amdgcn_sched_barrier(0);
#pragma unroll
            for (int i = 0; i < 8; ++i) { const int st = hb * 8 + i, cg = (dir == 0) ? cg0 + st : cg0 + 31 - st; const int unit = (cg * 4 + h) * 2 + dir;
                if (el < 16384) *(GAS v2u*)(SIC + (size_t)unit * 16384 + el) = pack4bf(val); else *(GAS f32x4*)(SIN + unit * 128 + (el - 16384)) = val;
                if (el == 0) SIM[unit] = m;
                const float mn = fmaxf(fv[i] + m, gv[i]); const float dec = __expf(fv[i] + m - mn), inj = __expf(gv[i] - mn);
                val = val * dec + uv[i] * inj; m = mn; }
        }
    }
    { constexpr int TOT = 256 * QSTR, NB = 4;
      float z_ = 0.f; asm volatile("" : "+v"(z_));
      for (int it0 = gt; it0 < TOT; it0 += NT * NB) {
          f32x4 u1[NB], u2[NB]; float f2[NB], g1[NB], g2[NB];
#pragma unroll
          for (int k = 0; k < NB; ++k) { const int it = it0 + k * NT; if (it < TOT) { const int chain = it / QSTR, el = (it % QSTR) * 4; const int b = chain >> 3, h = (chain >> 1) & 3, dir = chain & 1;
              const int c1 = 2 * b + dir, c2 = 2 * b + 1 - dir;
              const int un1 = (c1 * 4 + h) * 2 + dir, un2 = (c2 * 4 + h) * 2 + dir;
              u1[k] = *(const GAS f32x4*)(US + (size_t)un1 * USTR + el); u2[k] = *(const GAS f32x4*)(US + (size_t)un2 * USTR + el); g1[k] = FG[un1 * 2 + 1]; f2[k] = FG[un2 * 2]; g2[k] = FG[un2 * 2 + 1]; } }
          __builtin_amdgcn_sched_barrier(0);
#pragma unroll
          for (int k = 0; k < NB; ++k) { const int it = it0 + k * NT; if (it < TOT) { const int chain = it / QSTR, el = (it % QSTR) * 4; const int b = chain >> 3, h = (chain >> 1) & 3, dir = chain & 1;
              const int c1 = 2 * b + dir, c2 = 2 * b + 1 - dir; const int un1 = (c1 * 4 + h) * 2 + dir, un2 = (c2 * 4 + h) * 2 + dir;
              const float m1 = g1[k];
              const float mn = fmaxf(f2[k] + m1, g2[k]); const float dec = __expf(f2[k] + m1 - mn), inj = __expf(g2[k] - mn);
              const f32x4 fin = u1[k] * dec + u2[k] * inj;
              const size_t so = (size_t)((b * NL + l) * 2 + dir) * 4 + h;
              if (el < 16384) { *(GAS v2u*)(SIC + (size_t)un1 * 16384 + el) = (v2u){__builtin_bit_cast(unsigned, z_), __builtin_bit_cast(unsigned, z_)}; *(GAS v2u*)(SIC + (size_t)un2 * 16384 + el) = pack4bf(u1[k]); *(GAS f32x4*)(A.out + O_MC + so * 16384 + el) = fin; }
              else { *(GAS f32x4*)(SIN + un1 * 128 + (el - 16384)) = (f32x4){z_, z_, z_, z_}; *(GAS f32x4*)(SIN + un2 * 128 + (el - 16384)) = u1[k]; *(GAS f32x4*)(A.out + O_MN + so * 128 + (el - 16384)) = fin; }
              if (el == 0) { SIM[un1] = -INFINITY; SIM[un2] = m1; A.out[O_MM + so] = mn; } } }
      } }
}

__device__ __forceinline__ void p5_mlstm_out_unit(CArgs& A, Frame& F, const int l, const int cu, unsigned* queue) {
    int tid_o = F.tid; asm volatile("" : "+v"(tid_o));
    const int tid = tid_o, lane = tid & 63, w = F.wave, fr = lane & 15, fq = lane >> 4;
    const int h = cu & 3, cg = cu >> 2, row0 = cg * 128;
    LAS bf16* P = (LAS bf16*)(F.lds + RING_OFF); LAS unsigned char* CI = F.lds + RING_OFF + 34816; LAS unsigned char* VI = CI + 32768;
    LAS bf16* NB = (LAS bf16*)(F.lds + RING_OFF + 100352);
    LAS float* arr = (LAS float*)(F.lds + RING_OFF + 100608);
    LAS float* igf = arr, *lff = arr + 128, *igb = arr + 256, *lfb = arr + 384;
    const int s0 = tid >> 4, ch = tid & 15;
    const int unit0 = (cg * 4 + h) * 2;
    bf16x8 vvv[4], kkk[4], qa[4], cv0[4], cv1[4];
#pragma unroll
    for (int i = 0; i < 4; ++i) vvv[i] = *(const bf16x8*)(((bf16*)(A.ws + WS_PROJ)) + (size_t)(row0 + s0 + 32 * i) * NIN + C_MV + h * 128 + ch * 8);
#pragma unroll
    for (int i = 0; i < 4; ++i) kkk[i] = *(const bf16x8*)(((bf16*)(A.ws + WS_PROJ)) + (size_t)(row0 + s0 + 32 * i) * NIN + C_MK + h * 128 + ch * 8);
#pragma unroll
    for (int ks = 0; ks < 4; ++ks) qa[ks] = *(const bf16x8*)(((bf16*)(A.ws + WS_PROJ)) + (size_t)(row0 + 16 * w + fr) * NIN + C_MQ + h * 128 + ks * 32 + fq * 8);
#pragma unroll
    for (int i = 0; i < 4; ++i) cv0[i] = *(const bf16x8*)(((bf16*)(A.ws + WS_SIC)) + (size_t)unit0 * 16384 + (s0 + 32 * i) * 128 + ch * 8);
#pragma unroll
    for (int i = 0; i < 4; ++i) cv1[i] = *(const bf16x8*)(((bf16*)(A.ws + WS_SIC)) + (size_t)(unit0 + 1) * 16384 + (s0 + 32 * i) * 128 + ch * 8);
    float g0_ = 0.f, g1_ = 0.f, g2_ = 0.f, g3_ = 0.f, n0_ = 0.f, n1_ = 0.f;
    if (tid < 128) { const float* pr = ((const float*)(A.ws + WS_GATES)) + (size_t)(row0 + tid) * 16 + h; g0_ = pr[0]; g1_ = pr[4]; g2_ = pr[8]; g3_ = pr[12];
        n0_ = ((float*)(A.ws + WS_SIN))[unit0 * 128 + tid]; n1_ = ((float*)(A.ws + WS_SIN))[(unit0 + 1) * 128 + tid]; }
    unsigned tk_ = 0u; if (tid == 0) tk_ = xb_add(queue, 1u);
    __builtin_amdgcn_sched_barrier(0);
    __syncthreads();
    if (tid == 0) F.MISC[14] = tk_;
    if (tid < 128) { const float* gb = A.in[17] + l * 16 + h;
        igf[tid] = g0_ + gb[0]; lff[tid] = logsigf(g1_ + gb[4]); igb[tid] = g2_ + gb[8]; lfb[tid] = logsigf(g3_ + gb[12]); NB[tid] = (bf16)f2bf(n0_); }
#pragma unroll
    for (int i = 0; i < 4; ++i) *(LAS bf16x8*)(P + (s0 + 32 * i) * 136 + ch * 8) = kkk[i];
#pragma unroll
    for (int i = 0; i < 4; ++i) { const int s = s0 + 32 * i; *(LAS bf16x8*)(VI + (unsigned)(s >> 5) * 8192u + dui_off_b((unsigned)(s & 31), (unsigned)ch)) = vvv[i]; }
#pragma unroll
    for (int i = 0; i < 4; ++i) { const int dd = s0 + 32 * i; *(LAS bf16x8*)(CI + (unsigned)(dd >> 5) * 8192u + dui_off_b((unsigned)(dd & 31), (unsigned)ch)) = cv0[i]; }
    __syncthreads();
    if (w < 2) {
        const int d = w; const int unit = unit0 + d;
        const float m_in = ((float*)(A.ws + WS_SIM))[unit];
        LAS float* igp = d ? igb : igf; LAS float* lfp = d ? lfb : lff;
        LAS float* rowt = arr + 512 + d * 512; LAS float* colt = rowt + 128; LAS float* ain = rowt + 256; LAS float* flo = rowt + 384;
        const int j0 = d ? 127 - 2 * lane : 2 * lane, j1 = d ? 126 - 2 * lane : 2 * lane + 1;
        float bc0, bc1; wave_scan_add2(lfp[j0], lfp[j1], lane, bc0, bc1);
        const float ct0 = igp[j0] - bc0, ct1 = igp[j1] - bc1;
        float pm0, pm1; wave_scan_max2(ct0, ct1, lane, pm0, pm1);
        { const float inter = bc0 + m_in, mr = fmaxf(inter, bc0 + pm0); colt[j0] = ct0; rowt[j0] = bc0 - mr; ain[j0] = __expf(inter - mr); flo[j0] = __expf(-mr); }
        { const float inter = bc1 + m_in, mr = fmaxf(inter, bc1 + pm1); colt[j1] = ct1; rowt[j1] = bc1 - mr; ain[j1] = __expf(inter - mr); flo[j1] = __expf(-mr); }
    }
    f32x4 sacc[8];
#pragma unroll
    for (int sh = 0; sh < 2; ++sh) { bf16x8 kbv[16];
#pragma unroll
        for (int i = 0; i < 16; ++i) kbv[i] = *(const LAS bf16x8*)(P + (16 * (sh * 4 + (i >> 2)) + fr) * 136 + (i & 3) * 32 + fq * 8);
        __builtin_amdgcn_sched_barrier(0);
#pragma unroll
        for (int i = 0; i < 16; ++i) { const int st = sh * 4 + (i >> 2); if ((i & 3) == 0) sacc[st] = (f32x4){0.f, 0.f, 0.f, 0.f}; sacc[st] = MFMA16(qa[i & 3], kbv[i], sacc[st]); } }
    f32x4 hsum[8];
#pragma unroll
    for (int et = 0; et < 8; ++et) hsum[et] = (f32x4){0.f, 0.f, 0.f, 0.f};
    unsigned ta[8][2];
#pragma unroll
    for (int c = 0; c < 8; ++c) { ta[c][0] = (unsigned)(uintptr_t)CI + tr16_addr((unsigned)lane, (unsigned)c, 0u); ta[c][1] = (unsigned)(uintptr_t)CI + tr16_addr((unsigned)lane, (unsigned)c, 1u); }
    const bf16x8 zero8 = (bf16x8){0, 0, 0, 0, 0, 0, 0, 0};
    const bf16x8 ones = (fr == 0) ? (bf16x8){0x3F80, 0x3F80, 0x3F80, 0x3F80, 0x3F80, 0x3F80, 0x3F80, 0x3F80} : zero8;
    for (int d = 0; d < 2; ++d) {
        const int unit = (cg * 4 + h) * 2 + d;
        LAS float* rowt = arr + 512 + d * 512; LAS float* colt = rowt + 128; LAS float* ain = rowt + 256; LAS float* flo = rowt + 384;
        __syncthreads();
        if (d == 1) {
#pragma unroll
          for (int i = 0; i < 4; ++i) { const int dd = s0 + 32 * i; *(LAS bf16x8*)(CI + (unsigned)(dd >> 5) * 8192u + dui_off_b((unsigned)(dd & 31), (unsigned)ch)) = cv1[i]; }
          if (tid < 128) NB[tid] = (bf16)f2bf(n1_); }
        float rt[4];
#pragma unroll
        for (int r = 0; r < 4; ++r) rt[r] = rowt[16 * w + fq * 4 + r];
#pragma unroll
        for (int st = 0; st < 8; ++st) { const int s = 16 * st + fr; const float ct = colt[s];
#pragma unroll
            for (int r = 0; r < 4; ++r) { const int j = 16 * w + fq * 4 + r; const bool ok = d ? (s >= j) : (s <= j);
                const float p = ok ? sacc[st][r] * KSCALE * __expf(rt[r] + ct) : 0.f; P[j * 136 + s] = (bf16)f2bf(p); } }
        __syncthreads();
        f32x4 acc[9];
#pragma unroll
        for (int et = 0; et < 9; ++et) acc[et] = (f32x4){0.f, 0.f, 0.f, 0.f};
#define P5_KSTEP(KS, IMGOFF, AF, B9) do { \
            s16x4v bl[8], bh[8]; \
            _Pragma("unroll") for (int c = 0; c < 8; ++c) { bl[c] = tr16_read<(IMGOFF) + (KS) * 8192>(ta[c][0]); bh[c] = tr16_read<(IMGOFF) + (KS) * 8192>(ta[c][1]); } \
            asm volatile("s_waitcnt lgkmcnt(0)" ::: "memory"); __builtin_amdgcn_sched_barrier(0); \
            _Pragma("unroll") for (int c = 0; c < 8; ++c) acc[c] = MFMA16(AF, TR_PK(bl[c], bh[c]), acc[c]); \
            acc[8] = MFMA16(AF, B9, acc[8]); } while (0)
        { bf16x8 nf[4];
#pragma unroll
          for (int ks = 0; ks < 4; ++ks) { const bf16x8 nv = *(const LAS bf16x8*)(NB + ks * 32 + fq * 8); nf[ks] = (fr == 0) ? nv : zero8; }
          P5_KSTEP(0, 0, qa[0], nf[0]); P5_KSTEP(1, 0, qa[1], nf[1]); P5_KSTEP(2, 0, qa[2], nf[2]); P5_KSTEP(3, 0, qa[3], nf[3]); }
        float ai[4], fl[4];
#pragma unroll
        for (int r = 0; r < 4; ++r) { ai[r] = ain[16 * w + fq * 4 + r]; fl[r] = flo[16 * w + fq * 4 + r]; }
#pragma unroll
        for (int et = 0; et < 9; ++et)
#pragma unroll
            for (int r = 0; r < 4; ++r) acc[et][r] *= ai[r];
        { bf16x8 pa[4];
#pragma unroll
          for (int ks = 0; ks < 4; ++ks) pa[ks] = *(const LAS bf16x8*)(P + (16 * w + fr) * 136 + ks * 32 + fq * 8);
          P5_KSTEP(0, 32768, pa[0], ones); P5_KSTEP(1, 32768, pa[1], ones); P5_KSTEP(2, 32768, pa[2], ones); P5_KSTEP(3, 32768, pa[3], ones); }
#undef P5_KSTEP
#pragma unroll
        for (int r = 0; r < 4; ++r) { const float den = __shfl(acc[8][r], lane & 48); const float inv = 1.f / fmaxf(fabsf(den), fl[r]);
#pragma unroll
            for (int et = 0; et < 8; ++et) hsum[et][r] += acc[et][r] * inv; }
    }
#pragma unroll
    for (int r = 0; r < 4; ++r) { float ss = 0.f;
#pragma unroll
        for (int et = 0; et < 8; ++et) ss += hsum[et][r] * hsum[et][r];
        ss += __shfl_xor(ss, 1); ss += __shfl_xor(ss, 2); ss += __shfl_xor(ss, 4); ss += __shfl_xor(ss, 8);
        const float rn = rsqrtf(ss * (1.f / 128.f) + EPS); const int row = row0 + 16 * w + fq * 4 + r;
#pragma unroll
        for (int et = 0; et < 8; ++et) { const int e = 16 * et + fr; const float g = A.in[18][(l * 4 + h) * 128 + e]; const float mo = bf2f(((bf16*)(A.ws + WS_PROJ))[(size_t)row * NIN + C_MO + h * 128 + e]);
            ((bf16*)(A.ws + WS_CAT))[(size_t)row * DM + 1024 + h * 128 + e] = (bf16)f2bf(hsum[et][r] * rn * g / (1.f + __expf(-mo))); } }
}

__device__ __forceinline__ void p5_attention(CArgs& A, Frame& F, const int F_L, char* lds) {
    const float L2E = 1.4426950408889634f;
    const float* lv = A.in[19] + F_L * 256;
    const float lam_init = 0.8f - 0.6f * expf(-0.3f * (float)F_L);
    const float lam = expf(wave_sum(lv[F.lane] * lv[64 + F.lane])) - expf(wave_sum(lv[128 + F.lane] * lv[192 + F.lane])) + lam_init;
    bf16* PROJ = (bf16*)(A.ws + WS_PROJ); bf16* KB = (bf16*)(A.ws + WS_KB); bf16* VB = (bf16*)(A.ws + WS_VB); bf16* CAT = (bf16*)(A.ws + WS_CAT); bf16* OD = (bf16*)(A.ws + WS_OD);
    for (int slot = F.vcu; slot < 256; slot += F.G) {
        for (int item = 0; item < 4; ++item) {
            if (slot >= 128 && item >= 1) break;
            const bool lat = item == 0; const int seq = lat ? LATKV : 256;
            const bool dif = (slot < 128) && (item <= 1);
            if (dif) {
                int row0, krow0, hd, t0;
                if (lat) { const int b = slot >> 6, qb = slot & 15; hd = (slot >> 4) & 3; row0 = MCTX + b * 4096 + qb * 256; krow0 = MCTX + b * LATKV; t0 = qb * 256; }
                else { const int b = slot >> 2; hd = slot & 3; row0 = b * 256; krow0 = b * 256; t0 = 0; }
                const bf16* Q = PROJ + (size_t)row0 * NIN + C_DQ + hd * 128; const bf16* K = KB + (size_t)krow0 * KVW + 256 + hd * 128; const bf16* V = VB + (size_t)krow0 * KVW + 256 + hd * 128;
                bf16* O1 = OD + (size_t)row0 * DM + hd * 128; bf16* O = CAT + (size_t)row0 * DM + 1536 + hd * 128;
                __syncthreads();
                att::attn_dense_body<true>(Q, NIN, 1, nullptr, lat ? 1 : 0, t0, K, V, KVW, O1, DM, seq, 0.125f * L2E, 8.f / 0.125f, lds);
                __syncthreads();
                att::attn_dense_body<true>(Q, NIN, 2, nullptr, lat ? 1 : 0, t0, K, V, KVW, O, DM, seq, 0.125f * L2E, 8.f / 0.125f, lds, O1, lam, A.in[20] + F_L * 128, 1.f - lam_init);
            } else {
                const int nu = lat ? 2 : 1;
                for (int k2 = 0; k2 < nu; ++k2) {
                    const int u = lat ? (slot - 128) * 2 + k2 : slot * 2 + (item - 2);
                    int row0, krow0, hh, t0;
                    if (lat) { const int b = u >> 7, qb = u & 15; hh = (u >> 4) & 7; row0 = MCTX + b * 4096 + qb * 256; krow0 = MCTX + b * LATKV; t0 = qb * 256; }
                    else { const int b = u >> 3; hh = u & 7; row0 = b * 256; krow0 = b * 256; t0 = 0; }
                    const bf16* Q = PROJ + (size_t)row0 * NIN + C_AQ + hh * 128; const bf16* K = KB + (size_t)krow0 * KVW + (hh >> 2) * 128; const bf16* V = VB + (size_t)krow0 * KVW + (hh >> 2) * 128;
                    bf16* O = CAT + (size_t)row0 * DM + hh * 128;
                    __syncthreads();
                    att::attn_dense_body<false>(Q, NIN, 0, A.in[16] + F_L * 256, lat ? 1 : 0, t0, K, V, KVW, O, DM, seq, 0.08838834764831845f * L2E, 8.f / 0.08838834764831845f, lds);
                }
            }
        }
    }
}

__global__ void __launch_bounds__(NWAVES * 64, 2) mega_fwd(Args args) {
    extern __shared__ __attribute__((aligned(16))) unsigned char lds[];
    Frame F;
    F.lds = (LAS unsigned char*)lds;
    F.MISC = (volatile LAS unsigned*)(F.lds + MISC_OFF);
    F.tid = threadIdx.x; F.lane = F.tid & 63; F.wave = __builtin_amdgcn_readfirstlane(F.tid >> 6);
    F.G = gridDim.x; { const int bx = blockIdx.x; F.vcu = (F.G % 8 == 0) ? (bx % 8) * (F.G / 8) + bx / 8 : bx; }
    F.ctl = (gu32*)(args.ws + WS_CTL);
#define A (*kargs())
    for (int u = F.tid; u < (LDS_BYTES - LDSCTL_OFF) / 4; u += NWAVES * 64) ((LAS unsigned*)(F.lds + LDSCTL_OFF))[u] = 0u;
    __syncthreads();
    (void)xcd_barrier_post((unsigned*)(F.ctl + CW_BAR), F.MISC + 8);
    if (F.tid == 0) ((unsigned*)(F.ctl + CW_XCC))[blockIdx.x] = xb_xcc_id() + 1u;
    F.gmode = 0; F.rbase = F.vcu * NWAVES; F.rend = M; F.rstep = F.G * NWAVES; F.gtile = 0;
    unsigned gbn = 0;
#define GRID_BAR() for (int rb_ = 0; rb_ < REP_BAR; ++rb_) do { XcdBarrier b_; b_.bar = (unsigned*)(A.ws + WS_CTL) + CW_BAR; b_.x = xb_xcc_id(); b_.st = (volatile LAS unsigned*)(F.lds + MISC_OFF) + 8; xcd_barrier(b_); } while (0)

    const int plim = args.limit; int pc = 0;
#define PH_ON() (pc++ < plim)
        if (PH_ON()) {
#ifndef X_P0
    for (int rep_ = 0; rep_ < REP_P0; ++rep_) p0_prologue(A, F);
#endif
    GRID_BAR();
        }
#ifndef NO_GROUP_MODE
    { int ok = (F.G == 256) ? 1 : 0;
      if (ok && F.tid < 64) { const unsigned* xc = (const unsigned*)(F.ctl + CW_XCC); const int x = F.tid & 7, j = F.tid >> 3;
          const unsigned id0 = __hip_atomic_load(xc + x + 8 * j, RLX_AGENT); ok = id0 != 0u;
#pragma unroll
          for (int k = 1; k < 4; ++k) ok &= (__hip_atomic_load(xc + x + 8 * (j + 8 * k), RLX_AGENT) == id0) ? 1 : 0; }
      const int all_ok = __syncthreads_and(ok);
      if (all_ok) { const int c = (int)blockIdx.x; const int panel = 8 * (c % 8) + (c / 8) % 8, kq = c / 64;
          F.gmode = 1; F.rbase = panel * 256 + kq * 64; F.rstep = 1; F.gtile = (panel * 256 + kq * 64) / 16; } }
#endif
#define SEAM() do { if (F.gmode) { const int c_ = (int)blockIdx.x; ++gbn; grp_barrier((unsigned*)(A.ws + WS_CTL) + CW_GRP + 64 * (8 * (c_ % 8) + (c_ / 8) % 8), 4u * gbn, (unsigned*)(A.ws + WS_CTL) + CW_BAR + XB_TMO); } else GRID_BAR(); } while (0)
        if (PH_ON()) {
    for (int rep_ = 0; rep_ < REP_T1; ++rep_) row_phase(A, F, nullptr, nullptr, nullptr, 0, 0, true, A.in[13] + 0, ((float*)(A.ws + WS_MOD)) + 2048, ((float*)(A.ws + WS_MOD)) + 0);
    SEAM();
        }
    for (int l = 0; l < NL; ++l) {
        { int t_ = threadIdx.x; asm volatile("" : "+v"(t_)); F.tid = t_; F.lane = t_ & 63; F.wave = __builtin_amdgcn_readfirstlane(t_ >> 6); }
        const float* mod = ((float*)(A.ws + WS_MOD)) + (size_t)l * 3 * 12288; const float* ng = A.in[13] + (size_t)l * 4 * DM;
        if (PH_ON()) {
        { pg8::Gemm g{((bf16*)(A.ws + WS_HN)), wptr(A, l, W_IN), M, C_MG, DM}; pg8::StaticOrder S; S.init(M, C_MG, F.G, (int)blockIdx.x);
          pg8::EpiBf16<0> E{((bf16*)(A.ws + WS_PROJ)), NIN};
#ifndef X_GEMM
          for (int rep_ = 0; rep_ < REP_GEMM; ++rep_) pg8::gemm_phase<pg8::EpiBf16<0>, pg8::StaticOrder, true, true>(F.lds + RING_OFF, g, S, E);
#endif
 }
        gates_part(A, F, l);
        GRID_BAR();
        }
        if (PH_ON()) {
#ifndef X_P2
        for (int rep_ = 0; rep_ < REP_P2; ++rep_) p2_postproj(A, F, l);
#endif
#ifndef X_P3
        p3_summary_units(A, F, l, REP_ML * REP_P3);
#endif
        GRID_BAR();
        }
        if (PH_ON()) {
#ifndef X_P4
        for (int rep_ = 0; rep_ < REP_ML; ++rep_) p4_scan(A, F, l);
#endif
        dep_signal((unsigned*)(A.ws + WS_CTL) + CW_DEP + 64 * l);
        }
        if (PH_ON()) {
#ifndef X_P5A
        for (int rep_ = 0; rep_ < REP_ATT; ++rep_) p5_attention(A, F, l, (char*)lds + RING_OFF);
#endif
        dep_wait((unsigned*)(A.ws + WS_CTL) + CW_DEP + 64 * l, (unsigned)F.G, (unsigned*)(A.ws + WS_CTL) + CW_BAR + XB_TMO);
        { int t_ = threadIdx.x; asm volatile("" : "+v"(t_)); F.tid = t_; F.lane = t_ & 63; F.wave = __builtin_amdgcn_readfirstlane(t_ >> 6); }
#ifndef X_P5M
        if (F.tid == 0) F.MISC[14] = xb_add((unsigned*)(A.ws + WS_CTL) + CW_DEP + 64 * l + 16, 1u);
        for (;;) {
            __syncthreads();
            const int u = (int)F.MISC[14];
            if (u >= 512 * REP_ML) break;
            p5_mlstm_out_unit(A, F, l, u & 511, (unsigned*)(A.ws + WS_CTL) + CW_DEP + 64 * l + 16);
        }
#endif
        GRID_BAR();
        }
        if (PH_ON()) {
        { pg8::Gemm g{((bf16*)(A.ws + WS_CAT)), wptr(A, l, W_OUT), M, DM, DM}; pg8::StaticOrder S; S.init(M, DM, F.G, (int)blockIdx.x);
          pg8::EpiBf16<0> E{((bf16*)(A.ws + WS_MIX)), DM};
#ifndef X_GEMM
          for (int rep_ = 0; rep_ < REP_GEMM; ++rep_) pg8::gemm_phase<pg8::EpiBf16<0>, pg8::StaticOrder, true, true>(F.lds + RING_OFF, g, S, E);
#endif
 }
        SEAM();
        }
        if (PH_ON()) {
        row_phase(A, F, ((bf16*)(A.ws + WS_MIX)), ng + DM, mod + 4096, (l == 0) ? 0 : 1, 0, true, ng + 2 * DM, mod + 8192, mod + 6144);
        SEAM();
        }
        if (PH_ON()) {
        { pg8::Gemm g{((bf16*)(A.ws + WS_HN)), wptr(A, l, W_1), M, DFF, DM}; pg8::StaticOrder S; S.init(M, DFF, F.G, (int)blockIdx.x);
          pg8::EpiBf16<2> E{((bf16*)(A.ws + WS_H)), DFF};
#ifndef X_GEMM
          for (int rep_ = 0; rep_ < REP_GEMM; ++rep_) pg8::gemm_phase<pg8::EpiBf16<2>, pg8::StaticOrder, true, true>(F.lds + RING_OFF, g, S, E);
#endif
 }
        SEAM();
        }
        if (PH_ON()) {
        { pg8::Gemm g{((bf16*)(A.ws + WS_H)), wptr(A, l, W_2), M, DM, DFF}; pg8::StaticOrder S; S.init(M, DM, F.G, (int)blockIdx.x);
          pg8::EpiBf16<0> E{((bf16*)(A.ws + WS_MIX)), DM};
#ifndef X_GEMM
          for (int rep_ = 0; rep_ < REP_GEMM; ++rep_) pg8::gemm_phase<pg8::EpiBf16<0>, pg8::StaticOrder, true, true>(F.lds + RING_OFF, g, S, E);
#endif
 }
        SEAM();
        }
        if (PH_ON()) {
        { const int ln = (l + 1 < NL) ? l + 1 : l; const float* modn = ((float*)(A.ws + WS_MOD)) + (size_t)ln * 3 * 12288; const float* ngn = A.in[13] + (size_t)ln * 4 * DM;
          row_phase(A, F, ((bf16*)(A.ws + WS_MIX)), ng + 3 * DM, mod + 10240, 1, (l + 1 < NL) ? 0 : 1, l + 1 < NL, ngn, modn + 2048, modn + 0); }
        if (l + 1 < NL) SEAM();
        }
    }
}

#undef A
extern "C" void kernel_launch(void* const* d_in, const int* in_sizes, int n_in, void* d_out, int out_size, void* d_ws, size_t ws_size, hipStream_t stream) {
    static int grid = 0;
    if (grid == 0) {
        if (n_in != 23 || (size_t)out_size != O_END || ws_size < WS_END) { fprintf(stderr, "kernel_launch: shape mismatch n_in %d out %d ws %zu\n", n_in, out_size, ws_size); grid = -1; return; }
        int dev = 0, cus = 0, per_cu = 0;
        if (hipGetDevice(&dev) != hipSuccess || hipDeviceGetAttribute(&cus, hipDeviceAttributeMultiprocessorCount, dev) != hipSuccess) { grid = -1; return; }
        if (hipFuncSetAttribute((const void*)mega_fwd, hipFuncAttributeMaxDynamicSharedMemorySize, LDS_BYTES) != hipSuccess) { fprintf(stderr, "kernel_launch: hipFuncSetAttribute failed\n"); grid = -1; return; }
        if (hipOccupancyMaxActiveBlocksPerMultiprocessor(&per_cu, (const void*)mega_fwd, NWAVES * 64, LDS_BYTES) != hipSuccess || per_cu < 1)
            fprintf(stderr, "kernel_launch: note: occupancy query reports %d workgroups per CU\n", per_cu);
        (void)hipGetLastError();
        grid = cus;
    }
    if (grid < 0) return;
    if (hipMemsetAsync((char*)d_ws + WS_CTL, 0, CTL_ZERO_BYTES, stream) != hipSuccess) return;
    Args a{}; a.limit = 1000000; a.pad = 0;
    for (int i = 0; i < 23; ++i) a.in[i] = (const float*)d_in[i];
    a.out = (float*)d_out; a.ws = (unsigned char*)d_ws;
    hipLaunchKernelGGL(mega_fwd, dim3(grid), dim3(NWAVES * 64), LDS_BYTES, stream, a);
#ifdef PROBE_LIMIT
    (void)hipMemsetAsync((char*)d_ws + WS_CTL, 0, CTL_ZERO_BYTES, stream);
    a.limit = PROBE_LIMIT;
    hipLaunchKernelGGL(mega_fwd, dim3(grid), dim3(NWAVES * 64), LDS_BYTES, stream, a);
#endif
    const hipError_t le = hipPeekAtLastError();
    if (le != hipSuccess) fprintf(stderr, "kernel_launch: launch failed: %s\n", hipGetErrorName(le));
}
```

```cpp
#include <hip/hip_runtime.h>
#ifndef REP_GEMM
#define REP_GEMM 1
#endif
#ifndef REP_ML
#define REP_ML 1
#endif
#ifndef REP_P6
#define REP_P6 1
#endif
#ifndef REP_P0
#define REP_P0 1
#endif
#ifndef REP_T1
#define REP_T1 1
#endif
#ifndef REP_BAR
#define REP_BAR 1
#endif
#ifndef REP_P2
#define REP_P2 1
#endif
#ifndef REP_P3
#define REP_P3 1
#endif
#ifndef REP_ATT
#define REP_ATT 1
#endif
#include <cstdio>
#include <cstdint>
namespace pg8 {
#define PG8_LAS __attribute__((address_space(3)))
typedef unsigned short bf16_t;
typedef short bf16x8 __attribute__((ext_vector_type(8)));
typedef float f32x4 __attribute__((ext_vector_type(4)));
typedef unsigned u32x4 __attribute__((ext_vector_type(4)));
constexpr int BM = 256, BK = 64, HALF = 128, HTB = HALF * BK * 2  , STAGE_BYTES = 8 * HTB, NXCD = 8, WGM = 8;

__host__ __device__ __forceinline__ int lds_byte(int r, int c) { const int st = (r >> 4) * 2 + (c >> 5), rr = r & 15, cc = c & 31, ob = rr * 64 + cc * 2; return st * 1024 + (ob ^ (((ob >> 9) & 1) << 5)); }
__host__ __device__ __forceinline__ void stage_rc(int b, int& R, int& C) { const int st = b / 1024, sb = b % 1024, swz = sb ^ (((sb >> 9) & 1) << 5); R = (st >> 1) * 16 + swz / 64; C = (st & 1) * 32 + (swz % 64) / 2; }
__host__ __device__ __forceinline__ int perm32(int rho) { const int n = rho >> 4, i = rho & 15; return 8 * (i >> 2) + 4 * n + (i & 3); }

struct Unit { int pm, pn; };
struct Gemm { const bf16_t* A; const bf16_t* Bt; int M, N, K; };

struct StaticOrder {
    int nM, nN, nwg, G, c;
    __host__ __device__ void init(int M, int N, int G_, int c_) { nM = M / BM; nN = N / BM; nwg = nM * nN; G = G_; c = c_; }
    __host__ __device__ bool next(int i, Unit& u) const {
        const long L = (long)i * G + c; if (L >= nwg) return false;
        int wgid = (int)L; { const int q = nwg / NXCD, r = nwg % NXCD, xcd = wgid % NXCD, off = wgid / NXCD; wgid = (xcd < r ? xcd * (q + 1) : r * (q + 1) + (xcd - r) * q) + off; }
        const int nig = WGM * nN, gid = wgid / nig, fm = gid * WGM, gsz = (nM - fm) < WGM ? (nM - fm) : WGM;
        u.pm = fm + ((wgid % nig) % gsz); u.pn = (wgid % nig) / gsz; return true;
    }
    __device__ __forceinline__ void a_ready(const Unit&) const {}
    __device__ __forceinline__ void done(const Unit&) const {}
};

__device__ __forceinline__ unsigned cvt_pk_bf16(float lo, float hi) { unsigned r; asm volatile("v_cvt_pk_bf16_f32 %0, %1, %2" : "=v"(r) : "v"(lo), "v"(hi)); return r; }
typedef float f32x2 __attribute__((ext_vector_type(2)));
template <int ACT  > struct EpiBf16 {
    static constexpr bool PERM = true, AFTER_DRAIN = false;
    bf16_t* O; int ldc;
    static constexpr bool ZEROES = true;
    __device__ __forceinline__ void operator()(f32x4 (&acc)[2][2][4][2], const Unit& u, int wr, int wc, int fr, int fq) const {
        const int row0 = u.pm * BM + wr * 64 + fr; const int col0 = u.pn * BM + wc * 32 + 8 * fq;
#pragma unroll
        for (int ai = 0; ai < 2; ++ai)
#pragma unroll
            for (int m = 0; m < 4; ++m) { bf16_t* rowp = O + (size_t)(row0 + ai * HALF + m * 16) * ldc + col0;
#pragma unroll
                for (int bj = 0; bj < 2; ++bj) { f32x4 v0 = acc[ai][bj][m][0], v1 = acc[ai][bj][m][1];
                    if (ACT == 2) {
#pragma unroll
                        for (int e = 0; e < 4; ++e) { const float a = fmaxf(v0[e], 0.f), b = fmaxf(v1[e], 0.f); v0[e] = a * a; v1[e] = b * b; } }
                    u32x4 w; w.x = cvt_pk_bf16(v0[0], v0[1]); w.y = cvt_pk_bf16(v0[2], v0[3]); w.z = cvt_pk_bf16(v1[0], v1[1]); w.w = cvt_pk_bf16(v1[2], v1[3]);
                    *(u32x4*)(rowp + bj * HALF) = w; acc[ai][bj][m][0] = (f32x4){0.f, 0.f, 0.f, 0.f}; acc[ai][bj][m][1] = (f32x4){0.f, 0.f, 0.f, 0.f}; } }
    }
};

template <class Epi, class Sched, bool ALIGN_EPI = false, bool SP2 = false>
__device__ __forceinline__ void gemm_phase(PG8_LAS unsigned char* lds, const Gemm g, const Sched& S, const Epi& E) {
    int tid_o = threadIdx.x; asm volatile("" : "+v"(tid_o));
    const int tid = tid_o, wid = __builtin_amdgcn_readfirstlane(tid >> 6), lane = tid & 63, wr = wid >> 2, wc = wid & 3, fr = lane & 15, fq = lane >> 4;
    const int K = g.K, nt = K / BK;
    unsigned voffA[2], voffB[2];
#pragma unroll
    for (int i = 0; i < 2; ++i) { int R, C; stage_rc(tid * 16 + i * 8192, R, C); const int Rb = Epi::PERM ? ((R & ~31) + perm32(R & 31)) : R;
        voffA[i] = (unsigned)(R * K + C) * 2u; voffB[i] = (unsigned)(Rb * K + C) * 2u; }
    const size_t kstep = (size_t)(BK * 2);
    const size_t hstep = (size_t)HALF * K * 2;
    const size_t tstep = 2 * hstep;
    const unsigned ldsw = (unsigned)wid * 1024u;
    const int aoff = lds_byte(wr * 64 + fr, fq * 8), boff = lds_byte(wc * 32 + fr, fq * 8);
#define PG8_SA(b, h) (((b) * 2 + (h)) * HTB)
#define PG8_SB(b, h) ((4 + (b) * 2 + (h)) * HTB)
#define PG8_STAGE(bufoff, gbase, voff) do { _Pragma("unroll") for (int _i = 0; _i < 2; ++_i) \
        __builtin_amdgcn_global_load_lds((const unsigned*)((const char*)(gbase) + (voff)[_i]), (PG8_LAS unsigned*)(lds + (bufoff) + ldsw + _i * 8192), 16, 0, 0); } while (0)
#define PG8_LDA(dst, b, h) do { _Pragma("unroll") for (int m = 0; m < 4; ++m) _Pragma("unroll") for (int k = 0; k < 2; ++k) dst[m][k] = *(const PG8_LAS bf16x8*)(lds + PG8_SA(b, h) + aoff + m * 2048 + k * 1024); } while (0)
#define PG8_LDB(dst, b, h) do { _Pragma("unroll") for (int n = 0; n < 2; ++n) _Pragma("unroll") for (int k = 0; k < 2; ++k) dst[n][k] = *(const PG8_LAS bf16x8*)(lds + PG8_SB(b, h) + boff + n * 2048 + k * 1024); } while (0)
#define PG8_MMA(ai, bj, At, Bt) do { __builtin_amdgcn_s_setprio(1); _Pragma("unroll") for (int m = 0; m < 4; ++m) _Pragma("unroll") for (int n = 0; n < 2; ++n) _Pragma("unroll") for (int k = 0; k < 2; ++k) \
        acc[ai][bj][m][n] = __builtin_amdgcn_mfma_f32_16x16x32_bf16(Bt[n][k], At[m][k], acc[ai][bj][m][n], 0, 0, 0); __builtin_amdgcn_s_setprio(0); } while (0)
#define PG8_WAIT_V(n) asm volatile("s_waitcnt vmcnt(" #n ")" ::: "memory")
#define PG8_WAIT_L(n) asm volatile("s_waitcnt lgkmcnt(" #n ")" ::: "memory")
#define PG8_BAR __builtin_amdgcn_s_barrier()
#define PG8_SCHED __builtin_amdgcn_sched_barrier(0)
    Unit cur, nxt; int ui = 0;
    if (!S.next(0, cur)) return;
    f32x4 acc[2][2][4][2];
#pragma unroll
    for (int a = 0; a < 2; ++a)
#pragma unroll
        for (int b = 0; b < 2; ++b)
#pragma unroll
            for (int m = 0; m < 4; ++m)
#pragma unroll
                for (int n = 0; n < 2; ++n) acc[a][b][m][n] = (f32x4){0.f, 0.f, 0.f, 0.f};
    bf16x8 At[4][2], B0[2][2], B1[2][2];
    const char* cA = (const char*)g.A + (size_t)cur.pm * tstep; const char* cB = (const char*)g.Bt + (size_t)cur.pn * tstep;
    S.a_ready(cur);
    if constexpr (SP2) {
        PG8_STAGE(PG8_SB(0, 0), cB, voffB); PG8_STAGE(PG8_SB(0, 1), cB + hstep, voffB); PG8_STAGE(PG8_SA(0, 0), cA, voffA); PG8_STAGE(PG8_SA(0, 1), cA + hstep, voffA);
        if (wr == 1) PG8_BAR;
        PG8_WAIT_V(2); PG8_BAR;
        PG8_STAGE(PG8_SB(1, 0), cB + kstep, voffB); PG8_STAGE(PG8_SA(1, 0), cA + kstep, voffA); PG8_STAGE(PG8_SB(1, 1), cB + hstep + kstep, voffB);
        PG8_WAIT_V(6); PG8_BAR;
    } else {
        PG8_STAGE(PG8_SB(0, 0), cB, voffB); PG8_STAGE(PG8_SA(0, 0), cA, voffA); PG8_STAGE(PG8_SB(0, 1), cB + hstep, voffB); PG8_STAGE(PG8_SA(0, 1), cA + hstep, voffA);
        if (wr == 1) PG8_BAR;
        PG8_WAIT_V(4); PG8_BAR;
        PG8_STAGE(PG8_SB(1, 0), cB + kstep, voffB); PG8_STAGE(PG8_SA(1, 0), cA + kstep, voffA); PG8_STAGE(PG8_SB(1, 1), cB + hstep + kstep, voffB);
        PG8_WAIT_V(6); PG8_BAR;
    }
    for (;;) {
        const bool has_next = S.next(ui + 1, nxt);
        const char* nA = has_next ? (const char*)g.A + (size_t)nxt.pm * tstep : cA; const char* nB = has_next ? (const char*)g.Bt + (size_t)nxt.pn * tstep : cB;
        for (int t = 0; t < nt; t += 2) {
            const bool last = (t == nt - 2);
            const char* a1 = cA + (size_t)(t + 1) * kstep;
            const char* a2 = last ? nA : cA + (size_t)(t + 2) * kstep; const char* b2 = last ? nB : cB + (size_t)(t + 2) * kstep;
            const char* a3 = a2 + kstep; const char* b3 = b2 + kstep;
            if (last && has_next) S.a_ready(nxt);
            if constexpr (SP2) {
            PG8_LDB(B0, 0, 0); PG8_LDB(B1, 0, 1); PG8_SCHED; PG8_LDA(At, 0, 0); PG8_STAGE(PG8_SA(1, 1), a1 + hstep, voffA);
            PG8_WAIT_V(8); PG8_WAIT_L(0); PG8_BAR; PG8_MMA(0, 0, At, B0); PG8_MMA(0, 1, At, B1); PG8_BAR; PG8_SCHED;
            PG8_LDA(At, 0, 1); PG8_STAGE(PG8_SB(0, 0), b2, voffB); PG8_STAGE(PG8_SB(0, 1), b2 + hstep, voffB); PG8_STAGE(PG8_SA(0, 0), a2, voffA);
            PG8_WAIT_V(8); PG8_WAIT_L(0); PG8_BAR; PG8_MMA(1, 0, At, B0); PG8_MMA(1, 1, At, B1); PG8_BAR; PG8_SCHED;
            PG8_LDB(B0, 1, 0); PG8_LDB(B1, 1, 1); PG8_SCHED; PG8_LDA(At, 1, 0); PG8_STAGE(PG8_SA(0, 1), a2 + hstep, voffA);
            PG8_WAIT_V(8); PG8_WAIT_L(0); PG8_BAR; PG8_MMA(0, 0, At, B0); PG8_MMA(0, 1, At, B1); PG8_BAR; PG8_SCHED;
            PG8_LDA(At, 1, 1); PG8_STAGE(PG8_SB(1, 0), b3, voffB); PG8_STAGE(PG8_SB(1, 1), b3 + hstep, voffB); PG8_STAGE(PG8_SA(1, 0), a3, voffA);
            PG8_WAIT_V(8); PG8_WAIT_L(0); PG8_BAR; PG8_MMA(1, 0, At, B0); PG8_MMA(1, 1, At, B1); PG8_BAR; PG8_SCHED;
            } else {
            PG8_LDB(B0, 0, 0); PG8_SCHED; PG8_LDA(At, 0, 0); PG8_STAGE(PG8_SA(1, 1), a1 + hstep, voffA);
            PG8_WAIT_L(8); PG8_BAR; PG8_WAIT_L(0); PG8_MMA(0, 0, At, B0); PG8_BAR; PG8_SCHED;
            PG8_LDB(B1, 0, 1); PG8_STAGE(PG8_SB(0, 0), b2, voffB);
            PG8_BAR; PG8_WAIT_L(0); PG8_MMA(0, 1, At, B1); PG8_BAR;
            PG8_LDA(At, 0, 1); PG8_STAGE(PG8_SA(0, 0), a2, voffA);
            PG8_BAR; PG8_WAIT_L(0); PG8_MMA(1, 0, At, B0); PG8_BAR; PG8_SCHED;
            PG8_STAGE(PG8_SB(0, 1), b2 + hstep, voffB);
            PG8_WAIT_V(6); PG8_BAR; PG8_MMA(1, 1, At, B1); PG8_BAR;
            PG8_LDB(B0, 1, 0); PG8_SCHED; PG8_LDA(At, 1, 0); PG8_STAGE(PG8_SA(0, 1), a2 + hstep, voffA);
            PG8_WAIT_L(8); PG8_BAR; PG8_WAIT_L(0); PG8_MMA(0, 0, At, B0); PG8_BAR; PG8_SCHED;
            PG8_LDB(B1, 1, 1); PG8_STAGE(PG8_SB(1, 0), b3, voffB);
            PG8_BAR; PG8_WAIT_L(0); PG8_MMA(0, 1, At, B1); PG8_BAR;
            PG8_LDA(At, 1, 1); PG8_STAGE(PG8_SA(1, 0), a3, voffA);
            PG8_BAR; PG8_WAIT_L(0); PG8_MMA(1, 0, At, B0); PG8_BAR; PG8_SCHED;
            PG8_STAGE(PG8_SB(1, 1), b3 + hstep, voffB);
            PG8_WAIT_V(6); PG8_BAR; PG8_MMA(1, 1, At, B1); PG8_BAR;
            }
        }
        if constexpr (ALIGN_EPI) { if (wr == 0) PG8_BAR; }
        if constexpr (!Epi::AFTER_DRAIN) { E(acc, cur, wr, wc, fr, fq); S.done(cur); }
        if (!has_next) break;
        if constexpr (!Epi::ZEROES) {
#pragma unroll
        for (int a = 0; a < 2; ++a)
#pragma unroll
            for (int b = 0; b < 2; ++b)
#pragma unroll
                for (int m = 0; m < 4; ++m)
#pragma unroll
                    for (int n = 0; n < 2; ++n) acc[a][b][m][n] = (f32x4){0.f, 0.f, 0.f, 0.f};
        }
        cur = nxt; cA = nA; cB = nB; ++ui;
        if constexpr (ALIGN_EPI) { if (wr == 1) PG8_BAR; }
    }
    PG8_WAIT_V(0);
    if constexpr (!ALIGN_EPI) { if (wr == 0) PG8_BAR; }
    PG8_BAR;
    if constexpr (Epi::AFTER_DRAIN) { E.fused(acc, cur, wr, wc, fr, fq, lds, wid, lane); S.done(cur); }
#undef PG8_SA
#undef PG8_SB
#undef PG8_STAGE
#undef PG8_LDA
#undef PG8_LDB
#undef PG8_MMA
#undef PG8_WAIT_V
#undef PG8_WAIT_L
#undef PG8_BAR
#undef PG8_SCHED
}
}
namespace att {
typedef unsigned short bf16;
using bf16x8 = __attribute__((ext_vector_type(8))) short;
using s16x4  = __attribute__((ext_vector_type(4))) short;
using f32x16 = __attribute__((ext_vector_type(16))) float;
using u32x4  = __attribute__((ext_vector_type(4))) unsigned;
constexpr int   D = 128, NW = 8, QBLK = 32, KVBLK = 64;
constexpr size_t SHM_V = KVBLK * D * 2, SHM_K = KVBLK * D * 2, SHM_ATTN = 2 * SHM_V + 2 * SHM_K + NW * 64 * 4;
constexpr int SDEPTH = 2;
#define KSWZ(row, colB) ((row) * 256 + ((colB) ^ (((row) & 7) << 4)))
#define SBAR() __builtin_amdgcn_sched_barrier(0)
__device__ __forceinline__ int crow(int r, int hi) { return (r & 3) + 8 * (r >> 2) + 4 * hi; }
__device__ __forceinline__ unsigned cvtpk(float lo, float hi) {
  unsigned r; asm volatile("v_cvt_pk_bf16_f32 %0, %1, %2" : "=v"(r) : "v"(lo), "v"(hi)); return r;
}
__device__ __forceinline__ bf16x8 ld8(const bf16* p) { return *reinterpret_cast<const bf16x8*>(p); }

__device__ __forceinline__ void partialSM(f32x16& p0, f32x16& p1, float& m_reg, float& mn, float& alpha, const float C, const float thr) {
  float pmax = p0[0];
#pragma unroll
  for (int r = 1; r < 16; ++r) pmax = fmaxf(pmax, p0[r]);
#pragma unroll
  for (int r = 0; r < 16; ++r) pmax = fmaxf(pmax, p1[r]);
  { auto rr = __builtin_amdgcn_permlane32_swap(__float_as_uint(pmax), __float_as_uint(pmax), false, false);
    pmax = fmaxf(__uint_as_float(rr[0]), __uint_as_float(rr[1])); }
  if (__builtin_expect(__all(pmax - m_reg <= thr), 1)) { mn = m_reg; alpha = 1.f; }
  else { mn = fmaxf(m_reg, pmax); alpha = __builtin_amdgcn_exp2f((m_reg - mn) * C); m_reg = mn; }
  float mnC = -mn * C;
#pragma unroll
  for (int r = 0; r < 16; ++r) p0[r] = fmaf(p0[r], C, mnC);
#pragma unroll
  for (int r = 0; r < 16; ++r) p1[r] = fmaf(p1[r], C, mnC);
#pragma unroll
  for (int r = 0; r < 16; ++r) p0[r] = __builtin_amdgcn_exp2f(p0[r]);
}
__device__ __forceinline__ void finishSM(f32x16& p0, f32x16& p1, float alpha, float& l_reg, bf16x8& pa0, bf16x8& pa1, bf16x8& pa2, bf16x8& pa3) {
#pragma unroll
  for (int r = 0; r < 16; ++r) p1[r] = __builtin_amdgcn_exp2f(p1[r]);
  float ps = 0;
#pragma unroll
  for (int r = 0; r < 16; ++r) ps += p0[r];
#pragma unroll
  for (int r = 0; r < 16; ++r) ps += p1[r];
  { auto rr = __builtin_amdgcn_permlane32_swap(__float_as_uint(ps), __float_as_uint(ps), false, false);
    ps = __uint_as_float(rr[0]) + __uint_as_float(rr[1]); }
  l_reg = l_reg * alpha + ps;
#define PK4(P, BASE, OUT) do { unsigned a0 = cvtpk(P[BASE + 0], P[BASE + 1]), a1 = cvtpk(P[BASE + 2], P[BASE + 3]);   \
    unsigned b0 = cvtpk(P[BASE + 4], P[BASE + 5]), b1 = cvtpk(P[BASE + 6], P[BASE + 7]);                              \
    auto r0 = __builtin_amdgcn_permlane32_swap(a0, b0, false, false); auto r1 = __builtin_amdgcn_permlane32_swap(a1, b1, false, false); \
    u32x4 w = {r0[0], r1[0], r0[1], r1[1]}; OUT = *reinterpret_cast<bf16x8*>(&w); } while (0)
  PK4(p0, 0, pa0); PK4(p0, 8, pa1); PK4(p1, 0, pa2); PK4(p1, 8, pa3);
#undef PK4
}
template <int ND> __device__ __forceinline__ void qkt(f32x16& p0, f32x16& p1, const bf16* Ks, const bf16x8* qr, int r32, int hi, const int kofsB) {
  p0 = f32x16{}; p1 = f32x16{};
#pragma unroll
  for (int d0 = 0; d0 < ND; ++d0) { int cb = (d0 * 16 + hi * 8) * 2 + kofsB;
    bf16x8 b0 = *reinterpret_cast<const bf16x8*>((const char*)Ks + KSWZ(r32, cb));
    bf16x8 b1 = *reinterpret_cast<const bf16x8*>((const char*)Ks + KSWZ(32 + r32, cb));
    p0 = __builtin_amdgcn_mfma_f32_32x32x16_bf16(b0, qr[d0], p0, 0, 0, 0);
    p1 = __builtin_amdgcn_mfma_f32_32x32x16_bf16(b1, qr[d0], p1, 0, 0, 0); }
}
__device__ __forceinline__ int v_st(int k, int c) { const int kk = (k & ~0xC) | ((k & 4) << 1) | ((k & 8) >> 1); return ((kk >> 3) * 4 + (c >> 5)) * 512 + ((kk & 7) * 32 + (c & 31)) * 2; }
__device__ __forceinline__ int v_rd_base(int lane) { return ((lane & 3) << 3) | (((lane >> 2) & 3) << 6) | (((lane >> 4) & 1) << 5) | (((lane >> 5) & 1) << 8); }
constexpr int v_rd_off(int d0, int ks, int half) { return d0 * 512 + ks * 4096 + half * 2048; }
template <int OFF> __device__ __forceinline__ s16x4 tr_read(int vb) {
  s16x4 r; asm volatile("ds_read_b64_tr_b16 %0, %1 offset:%2" : "=&v"(r) : "v"(vb), "i"(OFF) : "memory"); return r;
}
template <int D0> __device__ __forceinline__ void pv_one(f32x16& od, int vb, bf16x8 pa0, bf16x8 pa1, bf16x8 pa2, bf16x8 pa3) {
  const s16x4 l0 = tr_read<v_rd_off(D0, 0, 0)>(vb), h0 = tr_read<v_rd_off(D0, 0, 1)>(vb), l1 = tr_read<v_rd_off(D0, 1, 0)>(vb), h1 = tr_read<v_rd_off(D0, 1, 1)>(vb);
  const s16x4 l2 = tr_read<v_rd_off(D0, 2, 0)>(vb), h2 = tr_read<v_rd_off(D0, 2, 1)>(vb), l3 = tr_read<v_rd_off(D0, 3, 0)>(vb), h3 = tr_read<v_rd_off(D0, 3, 1)>(vb);
  asm volatile("s_waitcnt lgkmcnt(0)" ::: "memory"); SBAR();
#define PK(L, H) (bf16x8){L[0], L[1], L[2], L[3], H[0], H[1], H[2], H[3]}
  od = __builtin_amdgcn_mfma_f32_32x32x16_bf16(pa0, PK(l0, h0), od, 0, 0, 0);
  od = __builtin_amdgcn_mfma_f32_32x32x16_bf16(pa1, PK(l1, h1), od, 0, 0, 0);
  od = __builtin_amdgcn_mfma_f32_32x32x16_bf16(pa2, PK(l2, h2), od, 0, 0, 0);
  od = __builtin_amdgcn_mfma_f32_32x32x16_bf16(pa3, PK(l3, h3), od, 0, 0, 0);
#undef PK
}
__device__ __forceinline__ void pv_d0(f32x16* o, int vb, bf16x8 pa0, bf16x8 pa1, bf16x8 pa2, bf16x8 pa3) {
  pv_one<0>(o[0], vb, pa0, pa1, pa2, pa3); pv_one<1>(o[1], vb, pa0, pa1, pa2, pa3); pv_one<2>(o[2], vb, pa0, pa1, pa2, pa3); pv_one<3>(o[3], vb, pa0, pa1, pa2, pa3);
}
__device__ __forceinline__ unsigned short f2bf_rne(float f) { unsigned u = __builtin_bit_cast(unsigned, f); return (unsigned short)((u + 0x7fffu + ((u >> 16) & 1u)) >> 16); }

__device__ __forceinline__ float bfu(short v) { return __builtin_bit_cast(float, (unsigned)(unsigned short)v << 16); }
__device__ __forceinline__ bf16x8 pack8(const float* x) { u32x4 w = {cvtpk(x[0], x[1]), cvtpk(x[2], x[3]), cvtpk(x[4], x[5]), cvtpk(x[6], x[7])}; return *reinterpret_cast<bf16x8*>(&w); }
#define ROPE_PAIR(BA, BB, POS, F0, NF) do { float xa[8], xb[8]; _Pragma("unroll") for (int e = 0; e < 8; ++e) { xa[e] = bfu(qr[BA][e]); xb[e] = bfu(qr[BB][e]); \
    const float ang = (POS) * exp2f(-(float)((F0) + e) * (13.287712379549449f / (NF))); const float c = __cosf(ang), s = __sinf(ang); \
    const float ra = xa[e] * c - xb[e] * s, rb = xa[e] * s + xb[e] * c; xa[e] = ra; xb[e] = rb; } qr[BA] = pack8(xa); qr[BB] = pack8(xb); } while (0)
template <bool HALF> __device__ __forceinline__ void attn_dense_body(const bf16* __restrict__ Qb, const int ldq, const int qmode, const float* __restrict__ qgain, const int qrope, const int t0,
                                                const bf16* __restrict__ Kh, const bf16* __restrict__ Vh, const int ldk,
                                                bf16* __restrict__ Ob, const int ldo, const int seq, const float C, const float thr, char* lds,
                                                const bf16* O1b = nullptr, const float lam = 0.f, const float* __restrict__ cgain = nullptr, const float cscale = 0.f) {
  int tid_o = threadIdx.x; asm volatile("" : "+v"(tid_o));
  const int tid = tid_o, wid = tid >> 6, lane = tid & 63, r32 = lane & 31, hi = lane >> 5;
  bf16* V_lds = (bf16*)lds; bf16* K_lds = (bf16*)(lds + 2 * SHM_V);
  float* ws = (float*)(lds + 2 * SHM_V + 2 * SHM_K) + wid * 64; float* li_l = ws; float* al_l = ws + 32;
  constexpr int ND = HALF ? 4 : 8;
  float m_reg = -1e30f, l_reg = 0; f32x16 o[4] = {}; bf16x8 qr[ND];
  const int qoff = HALF ? ((qmode == 2) ? 64 : 0) : 0; const int kofsB = qoff * 2;
  const bf16* Qw = Qb + (long)(wid * QBLK + r32) * ldq + qoff + hi * 8;
#pragma unroll
  for (int d0 = 0; d0 < ND; ++d0) qr[d0] = ld8(Qw + d0 * 16);
  if constexpr (!HALF) {
    if (qgain != nullptr) {
      float ss = 0.f;
#pragma unroll
      for (int d0 = 0; d0 < 8; ++d0)
#pragma unroll
        for (int e = 0; e < 8; ++e) { const float x = bfu(qr[d0][e]); ss += x * x; }
      ss += __shfl_xor(ss, 32);
      const float rn = rsqrtf(ss * (1.f / 128.f) + 1e-6f);
#pragma unroll
      for (int d0 = 0; d0 < 8; ++d0) { float x[8];
#pragma unroll
        for (int e = 0; e < 8; ++e) x[e] = bfu(qr[d0][e]) * rn * qgain[d0 * 16 + hi * 8 + e];
        qr[d0] = pack8(x); }
    }
    if (qrope) {
      const int t = t0 + wid * QBLK + r32; const float ri = (float)(t >> 6), ci = (float)(t & 63);
      ROPE_PAIR(0, 4, ri, hi * 8, 32.f); ROPE_PAIR(1, 5, ri, 16 + hi * 8, 32.f); ROPE_PAIR(2, 6, ci, hi * 8, 32.f); ROPE_PAIR(3, 7, ci, 16 + hi * 8, 32.f);
    }
  } else {
    if (qrope) {
      const int t = t0 + wid * QBLK + r32; const float ri = (float)(t >> 6), ci = (float)(t & 63);
      ROPE_PAIR(0, 2, ri, hi * 8, 16.f); ROPE_PAIR(1, 3, ci, hi * 8, 16.f);
    }
  }
  const int sr = tid >> 4, sc = (tid & 15) * 8, vst0 = v_st(sr, sc), vst1 = v_st(32 + sr, sc);
  const int vb0 = (int)(uintptr_t)V_lds + v_rd_base(lane);
  struct { bf16x8 vs0, vs1, ks0, ks1; } sr_[SDEPTH];
#define SLOAD(i, k0) do { sr_[i].vs0 = ld8(&Vh[(long)((k0) + sr) * ldk + sc]); sr_[i].vs1 = ld8(&Vh[(long)((k0) + 32 + sr) * ldk + sc]); \
    sr_[i].ks0 = ld8(&Kh[(long)((k0) + sr) * ldk + sc]); sr_[i].ks1 = ld8(&Kh[(long)((k0) + 32 + sr) * ldk + sc]); } while (0)
#define SWRITE(b, i) do { *(bf16x8*)((char*)V_lds + (b) * SHM_V + vst0) = sr_[i].vs0;          \
    *(bf16x8*)((char*)V_lds + (b) * SHM_V + vst1) = sr_[i].vs1; int kc = sc * 2;               \
    *(bf16x8*)((char*)K_lds + (b) * SHM_K + KSWZ(sr, kc)) = sr_[i].ks0;                       \
    *(bf16x8*)((char*)K_lds + (b) * SHM_K + KSWZ(32 + sr, kc)) = sr_[i].ks1; } while (0)
#define SWAIT() do { if constexpr (SDEPTH == 2) asm volatile("s_waitcnt vmcnt(4)" ::: "memory"); else asm volatile("s_waitcnt vmcnt(0)" ::: "memory"); } while (0)
#define RESC(a) do { if (__any((a) < 1.f)) { if (hi == 0) al_l[r32] = (a); asm volatile("s_waitcnt lgkmcnt(0)" ::: "memory"); \
    _Pragma("unroll") for (int d = 0; d < 4; ++d) _Pragma("unroll") for (int r = 0; r < 16; ++r) o[d][r] *= al_l[crow(r, hi)]; } } while (0)
  f32x16 pA0, pA1, pB0, pB1; float mnA, mnB, alA, alB; bf16x8 pa0, pa1, pa2, pa3; const int NT = seq / KVBLK;
  constexpr int SE = 0, SO = SDEPTH - 1;
  SLOAD(SE, 0); asm volatile("s_waitcnt vmcnt(0)" ::: "memory"); SWRITE(0, SE); __syncthreads();
  qkt<ND>(pA0, pA1, K_lds, qr, r32, hi, kofsB); partialSM(pA0, pA1, m_reg, mnA, alA, C, thr);
  SLOAD(SO, KVBLK); if constexpr (SDEPTH == 2) { if (2 < NT) SLOAD(SE, 2 * KVBLK); }
  SWAIT(); SWRITE(1, SO); __syncthreads();
  for (int j = 1; j + 1 < NT; j += 2) {
    SBAR(); qkt<ND>(pB0, pB1, (bf16*)((char*)K_lds + SHM_K), qr, r32, hi, kofsB);
    finishSM(pA0, pA1, alA, l_reg, pa0, pa1, pa2, pa3); SBAR();
    SLOAD(SO, (j + SDEPTH) * KVBLK); SBAR();
    pv_d0(o, vb0, pa0, pa1, pa2, pa3); partialSM(pB0, pB1, m_reg, mnB, alB, C, thr);
    __syncthreads(); SWAIT(); SWRITE(0, SE);
    RESC(alB); __syncthreads();
    SBAR(); qkt<ND>(pA0, pA1, K_lds, qr, r32, hi, kofsB);
    finishSM(pB0, pB1, alB, l_reg, pa0, pa1, pa2, pa3); SBAR();
    if (SDEPTH == 1 || j + 3 < NT) SLOAD(SE, (j + 1 + SDEPTH) * KVBLK); SBAR();
    pv_d0(o, vb0 + (int)SHM_V, pa0, pa1, pa2, pa3); partialSM(pA0, pA1, m_reg, mnA, alA, C, thr);
    __syncthreads(); SWAIT(); SWRITE(1, SO);
    RESC(alA); __syncthreads();
  }
  SBAR(); qkt<ND>(pB0, pB1, (bf16*)((char*)K_lds + SHM_K), qr, r32, hi, kofsB);
  finishSM(pA0, pA1, alA, l_reg, pa0, pa1, pa2, pa3); SBAR();
  pv_d0(o, vb0, pa0, pa1, pa2, pa3); partialSM(pB0, pB1, m_reg, mnB, alB, C, thr);
  __syncthreads(); RESC(alB);
  finishSM(pB0, pB1, alB, l_reg, pa0, pa1, pa2, pa3); SBAR();
  pv_d0(o, vb0 + (int)SHM_V, pa0, pa1, pa2, pa3);
  if (hi == 0) li_l[r32] = l_reg; asm volatile("s_waitcnt lgkmcnt(0)" ::: "memory");
  float rli[16];
#pragma unroll
  for (int r = 0; r < 16; ++r) rli[r] = __builtin_amdgcn_rcpf(li_l[crow(r, hi)]);
  bf16* Ow = Ob + (long)(wid * QBLK) * ldo;
  if (O1b == nullptr) {
#pragma unroll
    for (int r = 0; r < 16; ++r) { int orow = crow(r, hi);
#pragma unroll
      for (int d0 = 0; d0 < 4; ++d0) Ow[(long)orow * ldo + d0 * 32 + r32] = f2bf_rne(o[d0][r] * rli[r]); }
  } else {
    const bf16* O1w = O1b + (long)(wid * QBLK) * ldo;
    float dg[4];
#pragma unroll
    for (int d0 = 0; d0 < 4; ++d0) dg[d0] = cgain[d0 * 32 + r32] * cscale;
#pragma unroll
    for (int r = 0; r < 16; ++r) { int orow = crow(r, hi); float dv[4]; float ss = 0.f;
#pragma unroll
      for (int d0 = 0; d0 < 4; ++d0) { const float o1 = __builtin_bit_cast(float, (unsigned)O1w[(long)orow * ldo + d0 * 32 + r32] << 16); dv[d0] = o1 - lam * (o[d0][r] * rli[r]); ss += dv[d0] * dv[d0]; }
      ss += __shfl_xor(ss, 1); ss += __shfl_xor(ss, 2); ss += __shfl_xor(ss, 4); ss += __shfl_xor(ss, 8); ss += __shfl_xor(ss, 16);
      const float rn = rsqrtf(ss * (1.f / 128.f) + 1e-6f);
#pragma unroll
      for (int d0 = 0; d0 < 4; ++d0) Ow[(long)orow * ldo + d0 * 32 + r32] = f2bf_rne(dv[d0] * rn * dg[d0]); }
  }
#undef SLOAD
#undef SWRITE
#undef SWAIT
#undef RESC
}
#undef KSWZ
#undef SBAR
#undef ROPE_PAIR
}
constexpr int NWAVES = 8;
constexpr int M = 16384, MCTX = 8192, DM = 2048, NIN = 5376, NINR = 5136, DFF = 8192, NL = 4;
constexpr int C_AQ = 0, C_AK = 1024, C_AV = 1280, C_MQ = 1536, C_MK = 2048, C_MV = 2560, C_MO = 3072, C_DQ = 3584, C_DK = 4096, C_DV = 4608, C_MG = 5120;
constexpr int KVW = 768, LATKV = 4352;
constexpr int NUNIT = 1024;
constexpr int USTR = 129 * 128;
constexpr float EPS = 1e-6f, KSCALE = 0.08838834764831845f;
constexpr size_t O_YP = 0, O_YS = 16777216, O_GK = 33554432, O_GV = 41943040, O_DK = 50331648, O_DV = 67108864, O_MC = 83886080, O_MN = 100663296, O_MM = 100794368, O_END = 100795392;
constexpr size_t MiB = 1u << 20;
constexpr size_t WS_CTL = 0, CTL_ZERO_BYTES = 1 * MiB;
constexpr size_t WS_MOD = 1 * MiB;
constexpr size_t WS_FG = 2 * MiB, WS_SIM = 2 * MiB + 65536, WS_SIN = 3 * MiB;
constexpr size_t WS_W = 4 * MiB, W_LSTRIDE = 93 * MiB, W_IN = 0, W_OUT = 21 * MiB, W_1 = 29 * MiB, W_2 = 61 * MiB;
constexpr size_t WS_HN = 376 * MiB, WS_PROJ = 440 * MiB, WS_KB = 608 * MiB, WS_VB = 633 * MiB, WS_CAT = 658 * MiB, WS_OD = 722 * MiB, WS_MIX = 786 * MiB, WS_H = 850 * MiB;
constexpr size_t WS_US = 1106 * MiB, WS_SIC = 1171 * MiB, WS_GATES = 1203 * MiB, WS_XB = 1204 * MiB, WS_END = 1268 * MiB;
static_assert(WS_W + 4 * W_LSTRIDE <= WS_HN && (size_t)NIN * DM * 2 <= W_OUT && WS_PROJ + (size_t)M * NIN * 2 <= WS_KB && WS_KB + (size_t)(MCTX + 2 * LATKV) * KVW * 2 <= WS_VB &&
              WS_VB + (size_t)(MCTX + 2 * LATKV) * KVW * 2 <= WS_CAT && WS_US + (size_t)NUNIT * USTR * 4 <= WS_SIC && WS_SIC + (size_t)NUNIT * 16384 * 2 <= WS_END, "d_ws map");
constexpr int CW_BAR = 4096, CW_XCC = 8192, CW_GRP = 16384, CW_DEP = 24576;
constexpr int RING_OFF = 0, RING_BYTES = 131072;
constexpr int LDSCTL_OFF = RING_BYTES, MISC_OFF = LDSCTL_OFF + 320;
constexpr int LDS_BYTES = 147456;

#define GAS __attribute__((address_space(1)))
#define LAS __attribute__((address_space(3)))
typedef unsigned short bf16;
typedef unsigned v4u __attribute__((ext_vector_type(4)));
typedef unsigned v2u __attribute__((ext_vector_type(2)));
typedef float f32x4 __attribute__((ext_vector_type(4)));
typedef short bf16x8 __attribute__((ext_vector_type(8)));
typedef GAS unsigned gu32;
#define RLX_AGENT __ATOMIC_RELAXED, __HIP_MEMORY_SCOPE_AGENT
#define LDS_WAIT() asm volatile("s_waitcnt lgkmcnt(0)" ::: "memory")
#define VM_WAIT() asm volatile("s_waitcnt vmcnt(0)" ::: "memory")
__device__ __forceinline__ unsigned f2bf(float f) { unsigned u = __builtin_bit_cast(unsigned, f); return (u + 0x7fffu + ((u >> 16) & 1u)) >> 16; }
__device__ __forceinline__ unsigned pk2(float lo, float hi) { return f2bf(lo) | (f2bf(hi) << 16); }
__device__ __forceinline__ float bf2f(unsigned short b) { return __builtin_bit_cast(float, (unsigned)b << 16); }
__device__ __forceinline__ float bflo(unsigned w) { return __builtin_bit_cast(float, w << 16); }
__device__ __forceinline__ float bfhi(unsigned w) { return __builtin_bit_cast(float, w & 0xffff0000u); }

#define XB_TMO      128
#define XB_XCNT(j)  (256  + 64 * (j))
#define XB_XSUB(j)  (1280 + 64 * (j))
#define XB_XGEN(j)  (2304 + 64 * (j))
#define XB_TOP      3328
#define XB_TOPGEN   3392
#define XCD_BAR_WORDS 3456
#define XB_SPIN_CAP (1u << 22)

__device__ __forceinline__ unsigned xb_ld(unsigned* p)              { return __hip_atomic_load(p, __ATOMIC_RELAXED, __HIP_MEMORY_SCOPE_AGENT); }
__device__ __forceinline__ unsigned xb_add(unsigned* p, unsigned v) { return __hip_atomic_fetch_add(p, v, __ATOMIC_RELAXED, __HIP_MEMORY_SCOPE_AGENT); }
__device__ __forceinline__ unsigned xb_xcc_id() { return (unsigned)__builtin_amdgcn_s_getreg((3 << 11) | 20) & 0xFu; }
#define XB_SPIN(cond, bar) do { unsigned _sp = 0; while (cond) { __builtin_amdgcn_s_sleep(1); \
    if ((++_sp & 255u) == 0u) { if (xb_ld(&(bar)[XB_TMO])) break; if (_sp > XB_SPIN_CAP) { atomicAdd(&(bar)[XB_TMO], 1u); break; } } } } while (0)

struct XcdBarrier {
    unsigned* bar; unsigned x;
    volatile LAS unsigned* st;
};
__device__ __forceinline__ XcdBarrier xcd_barrier_post(unsigned* bar, volatile LAS unsigned* st) {
    XcdBarrier b; b.bar = bar; b.x = xb_xcc_id(); b.st = st;
    if (threadIdx.x == 0) (void)xb_add(&bar[XB_XCNT(b.x)], 1u);
    return b;
}
__device__ __forceinline__ void xcd_barrier_complete(unsigned* bar, unsigned x, unsigned& nloc, unsigned& nx) {
    const unsigned G = gridDim.x * gridDim.y * gridDim.z;
    unsigned sum, cnt, mine, sp = 0u;
    for (;;) {
        sum = 0u; cnt = 0u; mine = 0u;
#pragma unroll
        for (unsigned j = 0; j < 16; ++j) { const unsigned c = xb_ld(&bar[XB_XCNT(j)]); sum += c; cnt += (c > 0u) ? 1u : 0u; mine = (j == x) ? c : mine; }
        if (sum == G) break;
        __builtin_amdgcn_s_sleep(1);
        if ((++sp & 255u) == 0u) { if (xb_ld(&bar[XB_TMO])) break; if (sp > XB_SPIN_CAP) { atomicAdd(&bar[XB_TMO], 1u); break; } }
    }
    nloc = mine > 0u ? mine : 1u; nx = cnt > 0u ? cnt : 1u;
}
__device__ __forceinline__ void xcd_barrier(const XcdBarrier& b) {
    asm volatile("s_waitcnt vmcnt(0)" ::: "memory");
    __syncthreads();
    if (threadIdx.x == 0) {
        unsigned* bar = b.bar;
        __builtin_amdgcn_s_waitcnt(0);
        unsigned nloc = b.st[0], nx = b.st[1];
        if (nloc == 0u) { xcd_barrier_complete(bar, b.x, nloc, nx); b.st[0] = nloc; b.st[1] = nx; }
        const unsigned old = xb_add(&bar[XB_XSUB(b.x)], 1u);
        const unsigned gen = old / nloc;
        if (old + 1u == (gen + 1u) * nloc) {
            __builtin_amdgcn_fence(__ATOMIC_RELEASE, "agent");
            asm volatile("s_waitcnt vmcnt(0)" ::: "memory");
            const unsigned og = xb_add(&bar[XB_TOP], 1u);
            const unsigned tg = og / nx;
            if (og + 1u == (tg + 1u) * nx) xb_add(&bar[XB_TOPGEN], 1u);
            else XB_SPIN(xb_ld(&bar[XB_TOPGEN]) == tg, bar);
            __builtin_amdgcn_fence(__ATOMIC_ACQUIRE, "agent");
            xb_add(&bar[XB_XGEN(b.x)], 1u);
            asm volatile("s_waitcnt vmcnt(0)" ::: "memory");
        } else {
            XB_SPIN(xb_ld(&bar[XB_XGEN(b.x)]) == gen, bar);
            __builtin_amdgcn_fence(__ATOMIC_ACQUIRE, "agent");
            asm volatile("s_waitcnt vmcnt(0)" ::: "memory");
        }
    }
    __syncthreads();
}

__device__ __forceinline__ void grp_barrier(unsigned* ctr, const unsigned target, unsigned* tmo) {
    asm volatile("s_waitcnt vmcnt(0)" ::: "memory");
    __syncthreads();
    if (threadIdx.x == 0) {
        __builtin_amdgcn_s_waitcnt(0);
        (void)xb_add(ctr, 1u);
        unsigned sp = 0;
        while (xb_ld(ctr) < target) { __builtin_amdgcn_s_sleep(1); if ((++sp & 255u) == 0u) { if (xb_ld(tmo)) break; if (sp > XB_SPIN_CAP) { atomicAdd(tmo, 1u); break; } } }
        __builtin_amdgcn_fence(__ATOMIC_ACQUIRE, "agent");
        asm volatile("s_waitcnt vmcnt(0)" ::: "memory");
    }
    __syncthreads();
}

__device__ __forceinline__ void dep_signal(unsigned* ctr) {
    asm volatile("s_waitcnt vmcnt(0)" ::: "memory");
    __syncthreads();
    if (threadIdx.x == 0) { __builtin_amdgcn_s_waitcnt(0); __builtin_amdgcn_fence(__ATOMIC_RELEASE, "agent"); asm volatile("s_waitcnt vmcnt(0)" ::: "memory"); (void)xb_add(ctr, 1u); }
}
__device__ __forceinline__ void dep_wait(unsigned* ctr, const unsigned target, unsigned* tmo) {
    __syncthreads();
    if (threadIdx.x == 0) {
        unsigned sp = 0;
        while (xb_ld(ctr) < target) { __builtin_amdgcn_s_sleep(1); if ((++sp & 255u) == 0u) { if (xb_ld(tmo)) break; if (sp > XB_SPIN_CAP) { atomicAdd(tmo, 1u); break; } } }
        __builtin_amdgcn_fence(__ATOMIC_ACQUIRE, "agent");
        asm volatile("s_waitcnt vmcnt(0)" ::: "memory");
    }
    __syncthreads();
}

struct Args { const float* in[23]; float* out; unsigned char* ws; int limit; int pad; };
struct Frame {
    LAS unsigned char* lds;
    volatile LAS unsigned* MISC;
    gu32* ctl;
    int tid, lane, wave;
    int vcu, G;
    int rbase, rend, rstep;
    int gmode, gtile;
};
typedef const __attribute__((address_space(4))) Args CArgs;
__device__ __forceinline__ CArgs* kargs() { CArgs* p = (CArgs*)__builtin_amdgcn_kernarg_segment_ptr(); asm volatile("" : "+s"(p)); return p; }
__device__ __forceinline__ bf16* wptr(CArgs& A, int l, size_t off) { return (bf16*)(A.ws + WS_W + (size_t)l * W_LSTRIDE + off); }

__device__ __forceinline__ float wave_sum(float v) {
#pragma unroll
    for (int o = 1; o < 64; o <<= 1) v += __shfl_xor(v, o);
    return v;
}
#define MFMA16(a, b, c) __builtin_amdgcn_mfma_f32_16x16x32_bf16((a), (b), (c), 0, 0, 0)

__device__ __forceinline__ void transpose_item(const float* W, int ldw, int c0, int nblk, int K, bf16* WT, int row_off, LAS float* scr, int item, int lane) {
    const int kb = item / nblk, nb = item % nblk, k0 = 64 * kb, n0 = 32 * nb;
    { f32x4 wv_[8]; const int c4 = lane & 7;
#pragma unroll
      for (int i = 0; i < 8; ++i) { const int kk = 8 * i + (lane >> 3); wv_[i] = *(const GAS f32x4*)(W + (size_t)(k0 + kk) * ldw + c0 + n0 + c4 * 4); }
      __builtin_amdgcn_sched_barrier(0);
#pragma unroll
      for (int i = 0; i < 8; ++i) { const int kk = 8 * i + (lane >> 3); LAS float* d = scr + kk * 33 + c4 * 4; d[0] = wv_[i].x; d[1] = wv_[i].y; d[2] = wv_[i].z; d[3] = wv_[i].w; } }
    LDS_WAIT(); asm volatile("" ::: "memory");
    const int c = lane & 7;
#pragma unroll
    for (int j = 0; j < 4; ++j) { const int n = (lane >> 3) + 8 * j; const LAS float* s = scr + (8 * c) * 33 + n;
        v4u o; o.x = pk2(s[0 * 33], s[1 * 33]); o.y = pk2(s[2 * 33], s[3 * 33]); o.z = pk2(s[4 * 33], s[5 * 33]); o.w = pk2(s[6 * 33], s[7 * 33]);
        *(GAS v4u*)(WT + (size_t)(row_off + n0 + n) * K + k0 + 8 * c) = o; }
    LDS_WAIT(); asm volatile("" ::: "memory");
}
__device__ __forceinline__ void p0_prologue(CArgs& A, Frame& F) {
    LAS float* scr = (LAS float*)(F.lds + RING_OFF + F.wave * 8448);
    LAS float* SIL = (LAS float*)(F.lds + RING_OFF + 81920);
    for (int i = F.tid; i < 3 * DM; i += NWAVES * 64) { const int c = i >> 11, k = i & 2047; const float v = (c == 0) ? A.in[10][k] : A.in[2][(c - 1) * DM + k]; SIL[i] = v / (1.f + expf(-v)); }
    __syncthreads();
    { LAS float* PART = (LAS float*)(F.lds + RING_OFF + 106496);
      for (int item = F.vcu; item < NL * 64; item += F.G) {
          const int l = item / 64, jb = item % 64, kb = F.wave * 256;
          const float* Wp = A.in[11] + (size_t)l * DM * 12288 + (size_t)kb * 12288 + jb * 192 + F.lane * 4;
          f32x4 a0 = (f32x4){0.f, 0.f, 0.f, 0.f}, a1 = a0, a2 = a0;
          if (F.lane < 48)
          for (int k0 = 0; k0 < 256; k0 += 16) { f32x4 wv_[16];
#pragma unroll
              for (int k = 0; k < 16; ++k) wv_[k] = *(const GAS f32x4*)(Wp + (size_t)(k0 + k) * 12288);
              __builtin_amdgcn_sched_barrier(0);
#pragma unroll
              for (int k = 0; k < 16; ++k) { a0 = a0 + wv_[k] * SIL[kb + k0 + k]; a1 = a1 + wv_[k] * SIL[DM + kb + k0 + k]; a2 = a2 + wv_[k] * SIL[2 * DM + kb + k0 + k]; } }
          *(LAS f32x4*)(PART + (F.wave * 3 + 0) * 256 + F.lane * 4) = a0; *(LAS f32x4*)(PART + (F.wave * 3 + 1) * 256 + F.lane * 4) = a1; *(LAS f32x4*)(PART + (F.wave * 3 + 2) * 256 + F.lane * 4) = a2;
          __syncthreads();
          if (F.wave < 3 && F.lane < 48) { f32x4 sum = *(const GAS f32x4*)(A.in[12] + l * 12288 + jb * 192 + F.lane * 4);
#pragma unroll
              for (int w2 = 0; w2 < 8; ++w2) sum = sum + *(const LAS f32x4*)(PART + (w2 * 3 + F.wave) * 256 + F.lane * 4);
              *(GAS f32x4*)(((float*)(A.ws + WS_MOD)) + (size_t)(l * 3 + F.wave) * 12288 + jb * 192 + F.lane * 4) = sum; }
          __syncthreads();
      } }
    const int gw = F.vcu * NWAVES + F.wave, NGW = F.G * NWAVES;
    constexpr int I_A = 32 * 112, I_B = 32 * 48, I_O = 32 * 64, I_1 = 32 * 256, I_2 = 128 * 64, I_L = I_A + I_B + I_O + I_1 + I_2;
    for (int it = gw; it < NL * I_L; it += NGW) {
        const int l = it / I_L; int r = it % I_L;
        const float* win = A.in[14] + (size_t)l * DM * NINR;
        if (r < I_A) { transpose_item(win, NINR, 0, 112, DM, wptr(A, l, W_IN), 0, scr, r, F.lane); continue; } r -= I_A;
        if (r < I_B) { transpose_item(win, NINR, 3600, 48, DM, wptr(A, l, W_IN), 3584, scr, r, F.lane); continue; } r -= I_B;
        if (r < I_O) { transpose_item(A.in[15] + (size_t)l * DM * DM, DM, 0, 64, DM, wptr(A, l, W_OUT), 0, scr, r, F.lane); continue; } r -= I_O;
        if (r < I_1) { transpose_item(A.in[21] + (size_t)l * DM * DFF, DFF, 0, 256, DM, wptr(A, l, W_1), 0, scr, r, F.lane); continue; } r -= I_1;
        transpose_item(A.in[22] + (size_t)l * DFF * DM, DM, 0, 64, DFF, wptr(A, l, W_2), 0, scr, r, F.lane);
    }
    const int gt = F.vcu * NWAVES * 64 + F.tid, NT = F.G * NWAVES * 64;
    for (int it = gt; it < NL * 16 * 256; it += NT) {
        const int l = it >> 12, r = (it >> 8) & 15, k8 = (it & 255) * 8;
        v4u o = {0u, 0u, 0u, 0u};
        { const float* s = A.in[14] + (size_t)l * DM * NINR + (size_t)k8 * NINR + 3584 + r;
            o.x = pk2(s[0], s[NINR]); o.y = pk2(s[2 * NINR], s[3 * NINR]); o.z = pk2(s[4 * NINR], s[5 * NINR]); o.w = pk2(s[6 * NINR], s[7 * NINR]); }
        *(GAS v4u*)(wptr(A, l, W_IN) + (size_t)(C_MG + r) * DM + k8) = o;
    }
}

__device__ __forceinline__ void row_phase(CArgs& A, Frame& F, const bf16* y, const float* gA, const float* gate, const int xin, const int xout, const bool write_hn, const float* gB, const float* sc, const float* sh) {
    const int lane = F.lane;
    if (F.gmode) {
        const int row_b = F.rbase + F.wave * 8;
        const int cond = row_b < MCTX ? 0 : 1 + ((row_b - MCTX) >> 12);
        f32x4 gav[8], gtv[8], gs[8], shv[8];
        if (y) { const GAS f32x4* ga = (const GAS f32x4*)gA + lane; const GAS f32x4* gt = (const GAS f32x4*)(gate + (size_t)cond * 12288) + lane;
#pragma unroll
            for (int j = 0; j < 8; ++j) { gav[j] = ga[64 * j]; gtv[j] = gt[64 * j]; } }
        if (write_hn) { const GAS f32x4* gb = (const GAS f32x4*)gB + lane; const GAS f32x4* scp = (const GAS f32x4*)(sc + (size_t)cond * 12288) + lane; const GAS f32x4* shp = (const GAS f32x4*)(sh + (size_t)cond * 12288) + lane;
#pragma unroll
            for (int j = 0; j < 8; ++j) { gs[j] = gb[64 * j] * (scp[64 * j] + 1.f); shv[j] = shp[64 * j]; } }
        for (int row = row_b; row < row_b + 8; ++row) {
            f32x4 x[8]; v2u xb[8], yb[8];
            if (xin == 0) { const float* xr = (row < MCTX) ? A.in[0] + (size_t)row * DM : A.in[1] + (size_t)(row - MCTX) * DM;
#pragma unroll
                for (int j = 0; j < 8; ++j) x[j] = ((const GAS f32x4*)xr)[lane + 64 * j]; }
            else { const GAS v2u* xr = (const GAS v2u*)(((bf16*)(A.ws + WS_XB)) + (size_t)row * DM) + lane;
#pragma unroll
                for (int j = 0; j < 8; ++j) xb[j] = xr[64 * j]; }
            if (y) { const GAS v2u* yr = (const GAS v2u*)(y + (size_t)row * DM) + lane;
#pragma unroll
                for (int j = 0; j < 8; ++j) yb[j] = yr[64 * j]; }
            __builtin_amdgcn_sched_barrier(0);
            if (xin != 0) {
#pragma unroll
                for (int j = 0; j < 8; ++j) x[j] = (f32x4){bflo(xb[j].x), bfhi(xb[j].x), bflo(xb[j].y), bfhi(xb[j].y)}; }
            if (y) {
                f32x4 yv[8]; float ss = 0.f;
#pragma unroll
                for (int j = 0; j < 8; ++j) { const v2u w = yb[j]; yv[j] = (f32x4){bflo(w.x), bfhi(w.x), bflo(w.y), bfhi(w.y)}; ss += (yv[j].x * yv[j].x + yv[j].y * yv[j].y) + (yv[j].z * yv[j].z + yv[j].w * yv[j].w); }
                const float r = rsqrtf(wave_sum(ss) * (1.f / DM) + EPS);
#pragma unroll
                for (int j = 0; j < 8; ++j) x[j] = x[j] + gtv[j] * (yv[j] * r * gav[j]);
                if (xout) { GAS f32x4* xo = (GAS f32x4*)(A.out + (size_t)row * DM) + lane;
#pragma unroll
                    for (int j = 0; j < 8; ++j) xo[64 * j] = x[j]; }
                else { GAS v2u* xo = (GAS v2u*)(((bf16*)(A.ws + WS_XB)) + (size_t)row * DM) + lane;
#pragma unroll
                    for (int j = 0; j < 8; ++j) { v2u w; w.x = pk2(x[j].x, x[j].y); w.y = pk2(x[j].z, x[j].w); xo[64 * j] = w; } }
            }
            if (write_hn) {
                float ss = 0.f;
#pragma unroll
                for (int j = 0; j < 8; ++j) ss += (x[j].x * x[j].x + x[j].y * x[j].y) + (x[j].z * x[j].z + x[j].w * x[j].w);
                const float r = rsqrtf(wave_sum(ss) * (1.f / DM) + EPS);
                GAS v2u* ho = (GAS v2u*)(((bf16*)(A.ws + WS_HN)) + (size_t)row * DM) + lane;
#pragma unroll
                for (int j = 0; j < 8; ++j) { const f32x4 h = (x[j] * r) * gs[j] + shv[j]; v2u w; w.x = pk2(h.x, h.y); w.y = pk2(h.z, h.w); ho[64 * j] = w; }
            }
        }
        return;
    }
    for (int row = F.rbase + F.wave; row < F.rend; row += F.rstep) {
        const int cond = row < MCTX ? 0 : 1 + ((row - MCTX) >> 12);
        f32x4 x[8];
        v2u xb[8], yb[8]; f32x4 gav[8], gtv[8];
        if (xin == 0) { const float* xr = (row < MCTX) ? A.in[0] + (size_t)row * DM : A.in[1] + (size_t)(row - MCTX) * DM;
#pragma unroll
            for (int j = 0; j < 8; ++j) x[j] = ((const GAS f32x4*)xr)[lane + 64 * j]; }
        else { const GAS v2u* xr = (const GAS v2u*)(((bf16*)(A.ws + WS_XB)) + (size_t)row * DM) + lane;
#pragma unroll
            for (int j = 0; j < 8; ++j) xb[j] = xr[64 * j]; }
        if (y) { const GAS v2u* yr = (const GAS v2u*)(y + (size_t)row * DM) + lane; const GAS f32x4* ga = (const GAS f32x4*)gA + lane; const GAS f32x4* gt = (const GAS f32x4*)(gate + (size_t)cond * 12288) + lane;
#pragma unroll
            for (int j = 0; j < 8; ++j) yb[j] = yr[64 * j];
#pragma unroll
            for (int j = 0; j < 8; ++j) { gav[j] = ga[64 * j]; gtv[j] = gt[64 * j]; } }
        __builtin_amdgcn_sched_barrier(0);
        if (xin != 0) {
#pragma unroll
            for (int j = 0; j < 8; ++j) x[j] = (f32x4){bflo(xb[j].x), bfhi(xb[j].x), bflo(xb[j].y), bfhi(xb[j].y)}; }
        if (y) {
            f32x4 yv[8]; float ss = 0.f;
#pragma unroll
            for (int j = 0; j < 8; ++j) { const v2u w = yb[j]; yv[j] = (f32x4){bflo(w.x), bfhi(w.x), bflo(w.y), bfhi(w.y)}; ss += (yv[j].x * yv[j].x + yv[j].y * yv[j].y) + (yv[j].z * yv[j].z + yv[j].w * yv[j].w); }
            const float r = rsqrtf(wave_sum(ss) * (1.f / DM) + EPS);
#pragma unroll
            for (int j = 0; j < 8; ++j) x[j] = x[j] + gtv[j] * (yv[j] * r * gav[j]);
            if (xout) { GAS f32x4* xo = (GAS f32x4*)(A.out + (size_t)row * DM) + lane;
#pragma unroll
                for (int j = 0; j < 8; ++j) xo[64 * j] = x[j]; }
            else { GAS v2u* xo = (GAS v2u*)(((bf16*)(A.ws + WS_XB)) + (size_t)row * DM) + lane;
#pragma unroll
                for (int j = 0; j < 8; ++j) { v2u w; w.x = pk2(x[j].x, x[j].y); w.y = pk2(x[j].z, x[j].w); xo[64 * j] = w; } }
        }
        if (write_hn) {
            const GAS f32x4* gb = (const GAS f32x4*)gB + lane; const GAS f32x4* scp = (const GAS f32x4*)(sc + (size_t)cond * 12288) + lane; const GAS f32x4* shp = (const GAS f32x4*)(sh + (size_t)cond * 12288) + lane;
            f32x4 gbv[8], scv[8], shv[8];
#pragma unroll
            for (int j = 0; j < 8; ++j) { gbv[j] = gb[64 * j]; scv[j] = scp[64 * j]; shv[j] = shp[64 * j]; }
            __builtin_amdgcn_sched_barrier(0);
            float ss = 0.f;
#pragma unroll
            for (int j = 0; j < 8; ++j) ss += (x[j].x * x[j].x + x[j].y * x[j].y) + (x[j].z * x[j].z + x[j].w * x[j].w);
            const float r = rsqrtf(wave_sum(ss) * (1.f / DM) + EPS);
            GAS v2u* ho = (GAS v2u*)(((bf16*)(A.ws + WS_HN)) + (size_t)row * DM) + lane;
#pragma unroll
            for (int j = 0; j < 8; ++j) { const f32x4 h = (x[j] * r * gbv[j]) * (scv[j] + 1.f) + shv[j]; v2u w; w.x = pk2(h.x, h.y); w.y = pk2(h.z, h.w); ho[64 * j] = w; }
        }
    }
}

__device__ __forceinline__ void unpack8(const v4u w, float* x) { x[0] = bflo(w.x); x[1] = bfhi(w.x); x[2] = bflo(w.y); x[3] = bfhi(w.y); x[4] = bflo(w.z); x[5] = bfhi(w.z); x[6] = bflo(w.w); x[7] = bfhi(w.w); }
__device__ __forceinline__ v4u packv8(const float* x) { v4u w; w.x = pk2(x[0], x[1]); w.y = pk2(x[2], x[3]); w.z = pk2(x[4], x[5]); w.w = pk2(x[6], x[7]); return w; }
__device__ __forceinline__ void store8f(float* o, const float* x) { *(GAS f32x4*)o = (f32x4){x[0], x[1], x[2], x[3]}; *(GAS f32x4*)(o + 4) = (f32x4){x[4], x[5], x[6], x[7]}; }
__device__ __forceinline__ void gates_part(CArgs& A, Frame& F, const int l) {
    const int gw = F.vcu * NWAVES + F.wave, NGW = F.G * NWAVES, lane = F.lane;
    { LAS unsigned char* wl = F.lds + RING_OFF; const GAS v4u* wgsrc = (const GAS v4u*)(wptr(A, l, W_IN) + (size_t)C_MG * DM);
      __syncthreads();
      const int fr = lane & 15, fq = lane >> 4;
      if (F.gmode) {
          const int it = F.gtile + (F.wave & 3), kh = F.wave >> 2;
          const bf16* hp = ((bf16*)(A.ws + WS_HN)) + (size_t)(it * 16 + fr) * DM + kh * 1024 + fq * 8;
          bf16x8 av[32];
#pragma unroll
          for (int k = 0; k < 32; ++k) av[k] = *(const bf16x8*)(hp + k * 32);
          __builtin_amdgcn_sched_barrier(0);
          { v4u wv[8];
#pragma unroll
            for (int q = 0; q < 8; ++q) wv[q] = wgsrc[F.tid + q * (NWAVES * 64)];
            __builtin_amdgcn_sched_barrier(0);
#pragma unroll
            for (int q = 0; q < 8; ++q) { const int i = F.tid + q * (NWAVES * 64); *(LAS v4u*)(wl + (i >> 8) * 4112 + (i & 255) * 16) = wv[q]; } }
          __syncthreads();
          const LAS unsigned char* wp = wl + fr * 4112 + kh * 2048 + fq * 16;
          f32x4 acc = (f32x4){0.f, 0.f, 0.f, 0.f};
#pragma unroll
          for (int k = 0; k < 32; ++k) { const bf16x8 bv = *(const LAS bf16x8*)(wp + k * 64); acc = MFMA16(av[k], bv, acc); }
          LAS f32x4* part = (LAS f32x4*)(wl + 66048) + (F.wave & 3) * 64 + lane;
          if (kh == 1) *part = acc;
          __syncthreads();
          if (kh == 0) { acc = acc + *part;
              float* go = ((float*)(A.ws + WS_GATES)) + (size_t)(it * 16 + fq * 4) * 16 + fr;
#pragma unroll
              for (int r = 0; r < 4; ++r) go[r * 16] = acc[r]; }
          return;
      }
      for (int i = F.tid; i < 16 * DM / 8; i += NWAVES * 64) *(LAS v4u*)(wl + (i >> 8) * 4112 + (i & 255) * 16) = wgsrc[i];
      __syncthreads();
      for (int it = F.vcu + F.G * F.wave; it < M / 16; it += NGW) {
          const bf16* hp = ((bf16*)(A.ws + WS_HN)) + (size_t)(it * 16 + fr) * DM + fq * 8;
          const LAS unsigned char* wp = wl + fr * 4112 + fq * 16;
          f32x4 acc = (f32x4){0.f, 0.f, 0.f, 0.f};
          for (int k0 = 0; k0 < 64; k0 += 16) { bf16x8 av[16];
#pragma unroll
              for (int k = 0; k < 16; ++k) av[k] = *(const bf16x8*)(hp + (k0 + k) * 32);
              __builtin_amdgcn_sched_barrier(0);
#pragma unroll
              for (int k = 0; k < 16; ++k) { const bf16x8 bv = *(const LAS bf16x8*)(wp + (k0 + k) * 64); acc = MFMA16(av[k], bv, acc); } }
          float* go = ((float*)(A.ws + WS_GATES)) + (size_t)(it * 16 + fq * 4) * 16 + fr;
#pragma unroll
          for (int r = 0; r < 4; ++r) go[r * 16] = acc[r];
      } }
}
__device__ __forceinline__ void p2_postproj(CArgs& A, Frame& F, const int l) {
    const int gw = F.vcu * NWAVES + F.wave, NGW = F.G * NWAVES, lane = F.lane, c16 = lane & 15;
    const float L2T = 13.287712379549449f;
    float g1v[8], inv128[8], inv64[8];
#pragma unroll
    for (int e = 0; e < 8; ++e) { g1v[e] = A.in[16][l * 256 + 128 + c16 * 8 + e];
        inv128[e] = exp2f(-(float)((lane & 3) * 8 + e) * (L2T / 32.f)); inv64[e] = exp2f(-(float)((lane & 1) * 8 + e) * (L2T / 16.f)); }
    v4u n1 = {0u, 0u, 0u, 0u}, n2 = n1, n3 = n1;
    if (gw < M) { const bf16* pr0 = ((bf16*)(A.ws + WS_PROJ)) + (size_t)gw * NIN; n1 = *(const GAS v4u*)(pr0 + C_AK + lane * 8); n2 = *(const GAS v4u*)(pr0 + C_DK + lane * 8); n3 = *(const GAS v4u*)(pr0 + C_DV + lane * 8); }
    for (int row = gw; row < M; row += NGW) {
        const bool lat = row >= MCTX;
        float ri = 0.f, ci = 0.f; int krow, b, t;
        if (lat) { const int rr = row - MCTX; b = rr >> 12; t = rr & 4095; ri = (float)(t >> 6); ci = (float)(t & 63); krow = MCTX + b * LATKV + t; }
        else { b = row >> 8; t = row & 255; krow = row; }
        bf16* kb = ((bf16*)(A.ws + WS_KB)) + (size_t)krow * KVW; bf16* vb = ((bf16*)(A.ws + WS_VB)) + (size_t)krow * KVW;
        const size_t ob = (size_t)(b * NL + l) * 256 + t;
        const v4u w1 = n1, w2 = n2, w3 = n3;
        if (row + NGW < M) { const bf16* pn = ((bf16*)(A.ws + WS_PROJ)) + (size_t)(row + NGW) * NIN;
            n1 = *(const GAS v4u*)(pn + C_AK + lane * 8); n2 = *(const GAS v4u*)(pn + C_DK + lane * 8); n3 = *(const GAS v4u*)(pn + C_DV + lane * 8); }
        __builtin_amdgcn_sched_barrier(0);
        float x[8];
        unpack8(w1, x);
        { float ss = 0.f;
#pragma unroll
          for (int e = 0; e < 8; ++e) ss += x[e] * x[e];
          ss += __shfl_xor(ss, 1); ss += __shfl_xor(ss, 2); ss += __shfl_xor(ss, 4); ss += __shfl_xor(ss, 8);
          const float rn = rsqrtf(ss * (1.f / 128.f) + EPS);
          float kx[8];
#pragma unroll
          for (int e = 0; e < 8; ++e) kx[e] = x[e] * rn * g1v[e];
          if (lat) { const float pos = ((lane & 7) < 4) ? ri : ci;
#pragma unroll
              for (int e = 0; e < 8; ++e) { const float ang = pos * inv128[e], c = __cosf(ang), s = __sinf(ang); const float oth = __shfl_xor(kx[e], 8);
                  kx[e] = (c16 < 8) ? kx[e] * c - oth * s : oth * s + kx[e] * c; } }
          if (lane < 32) { *(GAS v4u*)(kb + lane * 8) = packv8(kx); if (!lat) store8f(A.out + O_GK + ob * 256 + lane * 8, kx); }
          else { *(GAS v4u*)(vb + (lane - 32) * 8) = w1; if (!lat) store8f(A.out + O_GV + ob * 256 + (lane - 32) * 8, x); } }
        unpack8(w2, x);
        if (lat) { const float pos = ((lane & 3) < 2) ? ri : ci;
#pragma unroll
            for (int e = 0; e < 8; ++e) { const float ang = pos * inv64[e], c = __cosf(ang), s = __sinf(ang); const float oth = __shfl_xor(x[e], 4);
                x[e] = ((lane & 7) < 4) ? x[e] * c - oth * s : oth * s + x[e] * c; }
            *(GAS v4u*)(kb + 256 + lane * 8) = packv8(x); }
        else { *(GAS v4u*)(kb + 256 + lane * 8) = w2; store8f(A.out + O_DK + ob * 512 + lane * 8, x); }
        *(GAS v4u*)(vb + 256 + lane * 8) = w3;
        if (!lat) { unpack8(w3, x); store8f(A.out + O_DV + ob * 512 + lane * 8, x); }
    }
    for (int base = gw; base < 512 * 24; base += 6 * NGW) { float cv[6];
#pragma unroll
      for (int k = 0; k < 6; ++k) { const int it = base + k * NGW; const int rowi = it / 24, j = it % 24; const int b = rowi >> 8, p = rowi & 255;
          const size_t cg = ((size_t)(b * NL + l) * 256 + p) * 256, cd = ((size_t)(b * NL + l) * 256 + p) * 512;
          const float* src = (j < 4) ? A.in[3] + cg + j * 64 : (j < 8) ? A.in[4] + cg + (j - 4) * 64 : (j < 16) ? A.in[5] + cd + (j - 8) * 64 : A.in[6] + cd + (j - 16) * 64;
          cv[k] = (it < 512 * 24) ? src[lane] : 0.f; }
      __builtin_amdgcn_sched_barrier(0);
#pragma unroll
      for (int k = 0; k < 6; ++k) { const int it = base + k * NGW; const int rowi = it / 24, j = it % 24; const int b = rowi >> 8, p = rowi & 255; const size_t krow = (size_t)MCTX + b * LATKV + 4096 + p;
          bf16* kb = ((bf16*)(A.ws + WS_KB)) + krow * KVW; bf16* vb = ((bf16*)(A.ws + WS_VB)) + krow * KVW;
          bf16* dst = (j < 4) ? kb + j * 64 : (j < 8) ? vb + (j - 4) * 64 : (j < 16) ? kb + 256 + (j - 8) * 64 : vb + 256 + (j - 16) * 64;
          if (it < 512 * 24) dst[lane] = (bf16)f2bf(cv[k]); } }
}

__device__ __forceinline__ void wave_scan_add2(const float a, const float b, const int lane, float& ia, float& ib) {
    float s = a + b;
#pragma unroll
    for (int o = 1; o < 64; o <<= 1) { const float t = __shfl_up(s, o); if (lane >= o) s += t; }
    ia = (s - (a + b)) + a; ib = s;
}
__device__ __forceinline__ void wave_scan_max2(const float a, const float b, const int lane, float& ia, float& ib) {
    float s = fmaxf(a, b);
#pragma unroll
    for (int o = 1; o < 64; o <<= 1) { const float t = __shfl_up(s, o); if (lane >= o) s = fmaxf(s, t); }
    const float prev = __shfl_up(s, 1); ia = (lane >= 1) ? fmaxf(prev, a) : a; ib = s;
}
__device__ __forceinline__ float wave_max(float v) {
#pragma unroll
    for (int o = 1; o < 64; o <<= 1) v = fmaxf(v, __shfl_xor(v, o));
    return v;
}
__device__ __forceinline__ float logsigf(float x) { return fminf(x, 0.f) - log1pf(expf(-fabsf(x))); }

__device__ __forceinline__ unsigned dui_off_b(unsigned row, unsigned ch) { return 256u * row + 16u * (ch ^ (((row & 3) << 2) | ((row >> 2) & 3))); }
__device__ __forceinline__ unsigned tr16_addr(unsigned lane, unsigned c, unsigned t) { const unsigned g = lane >> 4, q = (lane & 15) >> 2, p = lane & 3; return dui_off_b(8 * g + 4 * t + q, 2 * c + (p >> 1)) + 8 * (p & 1); }
typedef short s16x4v __attribute__((ext_vector_type(4)));
template <int OFF> __device__ __forceinline__ s16x4v tr16_read(unsigned addr) { s16x4v r; asm volatile("ds_read_b64_tr_b16 %0, %1 offset:%2" : "=&v"(r) : "v"(addr), "i"(OFF) : "memory"); return r; }
#define TR_PK(L, H) (bf16x8){L[0], L[1], L[2], L[3], H[0], H[1], H[2], H[3]}

__device__ __forceinline__ void p3_summary_units(CArgs& A, Frame& F, const int l, const int nrep) {
    const int tid = F.tid, lane = F.lane, w = F.wave, fr = lane & 15, fq = lane >> 4;
    LAS unsigned char* KWI = F.lds + RING_OFF;
    const int s0 = tid >> 4, ch = tid & 15;
    bf16x8 kvv[4], vvv[4]; float gi0 = 0.f, gf0 = 0.f, gi1 = 0.f, gf1 = 0.f;
#define P3_LOAD(U) do { const int dir_ = (U) & 1, h_ = ((U) >> 1) & 3, row0_ = ((U) >> 3) * 128; \
        _Pragma("unroll") for (int i = 0; i < 4; ++i) { const int s = s0 + 32 * i; \
            kvv[i] = *(const bf16x8*)(((bf16*)(A.ws + WS_PROJ)) + (size_t)(row0_ + s) * NIN + C_MK + h_ * 128 + ch * 8); vvv[i] = *(const bf16x8*)(((bf16*)(A.ws + WS_PROJ)) + (size_t)(row0_ + s) * NIN + C_MV + h_ * 128 + ch * 8); } \
        const float* pr = ((const float*)(A.ws + WS_GATES)) + (size_t)(row0_ + 2 * lane) * 16 + dir_ * 8 + h_; gi0 = pr[0]; gf0 = pr[4]; gi1 = pr[16]; gf1 = pr[20]; } while (0)
    const int nun = NUNIT * nrep;
    if (F.vcu < nun) P3_LOAD(F.vcu % NUNIT);
  for (int un = F.vcu; un < nun; un += F.G) {
    const int unit = un % NUNIT;
    const int dir = unit & 1, h = (unit >> 1) & 3;
    __builtin_amdgcn_sched_barrier(0);
    float wsv[4];
    { const float bi = A.in[17][((l * 2 + dir) * 2 + 0) * 4 + h], bfo = A.in[17][((l * 2 + dir) * 2 + 1) * 4 + h];
      const float ig0 = gi0 + bi, ig1 = gi1 + bi, l0 = logsigf(gf0 + bfo), l1 = logsigf(gf1 + bfo);
      float i0, i1; wave_scan_add2(l0, l1, lane, i0, i1);
      const float run = __shfl(i1, 63);
      const float a0 = (dir == 0) ? (run - i0) + ig0 : (i0 - l0) + ig0, a1 = (dir == 0) ? (run - i1) + ig1 : (i1 - l1) + ig1;
      const float G = wave_max(fmaxf(a0, a1));
      const float w0 = __expf(a0 - G) * KSCALE, w1 = __expf(a1 - G) * KSCALE;
      if (w == 0 && lane == 0) { ((float*)(A.ws + WS_FG))[unit * 2] = run; ((float*)(A.ws + WS_FG))[unit * 2 + 1] = G; }
#pragma unroll
      for (int i = 0; i < 4; ++i) { const int s = s0 + 32 * i; const float v0 = __shfl(w0, s >> 1), v1 = __shfl(w1, s >> 1); wsv[i] = (s & 1) ? v1 : v0; } }
    __syncthreads();
#pragma unroll
    for (int i = 0; i < 4; ++i) { const int s = s0 + 32 * i; float x[8];
#pragma unroll
        for (int e = 0; e < 8; ++e) x[e] = bf2f((unsigned short)kvv[i][e]) * wsv[i];
        const unsigned o = (unsigned)(s >> 5) * 8192u + dui_off_b((unsigned)(s & 31), (unsigned)ch);
        *(LAS v4u*)(KWI + o) = packv8(x); *(LAS bf16x8*)(KWI + 32768 + o) = vvv[i]; }
    __syncthreads();
    if (un + F.G < nun) P3_LOAD((un + F.G) % NUNIT);
    __builtin_amdgcn_sched_barrier(0);
    unsigned ta[8][2];
#pragma unroll
    for (int c = 0; c < 8; ++c) { ta[c][0] = (unsigned)(uintptr_t)KWI + tr16_addr((unsigned)lane, (unsigned)c, 0u); ta[c][1] = (unsigned)(uintptr_t)KWI + tr16_addr((unsigned)lane, (unsigned)c, 1u); }
    unsigned taw0 = ta[0][0], taw1 = ta[0][1];
#pragma unroll
    for (int c = 1; c < 8; ++c) { if (w == c) { taw0 = ta[c][0]; taw1 = ta[c][1]; } }
    f32x4 acc[9];
#pragma unroll
    for (int et = 0; et < 9; ++et) acc[et] = (f32x4){0.f, 0.f, 0.f, 0.f};
    const bf16x8 ones = (fr == 0) ? (bf16x8){0x3F80, 0x3F80, 0x3F80, 0x3F80, 0x3F80, 0x3F80, 0x3F80, 0x3F80} : (bf16x8){0, 0, 0, 0, 0, 0, 0, 0};
#define P3_KSTEP(KS) do { \
        const s16x4v al = tr16_read<(KS) * 8192>(taw0), ah = tr16_read<(KS) * 8192>(taw1); \
        s16x4v bl[8], bh[8]; \
        _Pragma("unroll") for (int c = 0; c < 8; ++c) { bl[c] = tr16_read<32768 + (KS) * 8192>(ta[c][0]); bh[c] = tr16_read<32768 + (KS) * 8192>(ta[c][1]); } \
        asm volatile("s_waitcnt lgkmcnt(0)" ::: "memory"); __builtin_amdgcn_sched_barrier(0); \
        const bf16x8 af = TR_PK(al, ah); \
        _Pragma("unroll") for (int c = 0; c < 8; ++c) acc[c] = MFMA16(af, TR_PK(bl[c], bh[c]), acc[c]); \
        acc[8] = MFMA16(af, ones, acc[8]); } while (0)
    P3_KSTEP(0); P3_KSTEP(1); P3_KSTEP(2); P3_KSTEP(3);
#undef P3_KSTEP
    float* uo = ((float*)(A.ws + WS_US)) + (size_t)unit * USTR;
    if (fr == 0) {
#pragma unroll
        for (int r = 0; r < 4; ++r) uo[16384 + 16 * w + fq * 4 + r] = acc[8][r]; }
#pragma unroll
    for (int et = 0; et < 8; ++et)
#pragma unroll
        for (int r = 0; r < 4; ++r) uo[(16 * w + fq * 4 + r) * 128 + 16 * et + fr] = acc[et][r];
  }
#undef P3_LOAD
}

constexpr int QSTR = USTR / 4;
__device__ __forceinline__ v2u pack4bf(const f32x4 v) { v2u w; w.x = pk2(v.x, v.y); w.y = pk2(v.z, v.w); return w; }
__device__ __forceinline__ void p4_scan(CArgs& A, Frame& F, const int l) {
    const int gt = F.vcu * NWAVES * 64 + F.tid, NT = F.G * NWAVES * 64;
    const float* US = (const float*)(A.ws + WS_US); const float* FG = (const float*)(A.ws + WS_FG);
    bf16* SIC = (bf16*)(A.ws + WS_SIC); float* SIN = (float*)(A.ws + WS_SIN); float* SIM = (float*)(A.ws + WS_SIM);
    for (int it = gt; it < 16 * QSTR; it += NT) {
        const int chain = it / QSTR, el = (it % QSTR) * 4; const int b = chain >> 3, h = (chain >> 1) & 3, dir = chain & 1, cg0 = 64 + 32 * b;
        const size_t si = (size_t)((b * NL + l) * 2 + dir) * 4 + h;
        f32x4 val = (el < 16384) ? *(const GAS f32x4*)(A.in[7] + si * 16384 + el) : *(const GAS f32x4*)(A.in[8] + si * 128 + (el - 16384)); float m = A.in[9][si];
        for (int hb = 0; hb < 4; ++hb) {
            f32x4 uv[8]; float fv[8], gv[8];
#pragma unroll
            for (int i = 0; i < 8; ++i) { const int st = hb * 8 + i, cg = (dir == 0) ? cg0 + st : cg0 + 31 - st; const int unit = (cg * 4 + h) * 2 + dir;
                uv[i] = *(const GAS f32x4*)(US + (size_t)unit * USTR + el); fv[i] = FG[unit * 2]; gv[i] = FG[unit * 2 + 1]; }
            __builtin_amdgcn_sched_barrier(0);
#pragma unroll
            for (int i = 0; i < 8; ++i) { const int st = hb * 8 + i, cg = (dir == 0) ? cg0 + st : cg0 + 31 - st; const int unit = (cg * 4 + h) * 2 + dir;
                if (el < 16384) *(GAS v2u*)(SIC + (size_t)unit * 16384 + el) = pack4bf(val); else *(GAS f32x4*)(SIN + unit * 128 + (el - 16384)) = val;
                if (el == 0) SIM[unit] = m;
                const float mn = fmaxf(fv[i] + m, gv[i]); const float dec = __expf(fv[i] + m - mn), inj = __expf(gv[i] - mn);
                val = val * dec + uv[i] * inj; m = mn; }
        }
    }
    { constexpr int TOT = 256 * QSTR, NB = 4;
      float z_ = 0.f; asm volatile("" : "+v"(z_));
      for (int it0 = gt; it0 < TOT; it0 += NT * NB) {
          f32x4 u1[NB], u2[NB]; float f2[NB], g1[NB], g2[NB];
#pragma unroll
          for (int k = 0; k < NB; ++k) { const int it = it0 + k * NT; if (it < TOT) { const int chain = it / QSTR, el = (it % QSTR) * 4; const int b = chain >> 3, h = (chain >> 1) & 3, dir = chain & 1;
              const int c1 = 2 * b + dir, c2 = 2 * b + 1 - dir;
              const int un1 = (c1 * 4 + h) * 2 + dir, un2 = (c2 * 4 + h) * 2 + dir;
              u1[k] = *(const GAS f32x4*)(US + (size_t)un1 * USTR + el); u2[k] = *(const GAS f32x4*)(US + (size_t)un2 * USTR + el); g1[k] = FG[un1 * 2 + 1]; f2[k] = FG[un2 * 2]; g2[k] = FG[un2 * 2 + 1]; } }
          __builtin_amdgcn_sched_barrier(0);
#pragma unroll
          for (int k = 0; k < NB; ++k) { const int it = it0 + k * NT; if (it < TOT) { const int chain = it / QSTR, el = (it % QSTR) * 4; const int b = chain >> 3, h = (chain >> 1) & 3, dir = chain & 1;
              const int c1 = 2 * b + dir, c2 = 2 * b + 1 - dir; const int un1 = (c1 * 4 + h) * 2 + dir, un2 = (c2 * 4 + h) * 2 + dir;
              const float m1 = g1[k];
              const float mn = fmaxf(f2[k] + m1, g2[k]); const float dec = __expf(f2[k] + m1 - mn), inj = __expf(g2[k] - mn);
              const f32x4 fin = u1[k] * dec + u2[k] * inj;
              const size_t so = (size_t)((b * NL + l) * 2 + dir) * 4 + h;
              if (el < 16384) { *(GAS v2u*)(SIC + (size_t)un1 * 16384 + el) = (v2u){__builtin_bit_cast(unsigned, z_), __builtin_bit_cast(unsigned, z_)}; *(GAS v2u*)(SIC + (size_t)un2 * 16384 + el) = pack4bf(u1[k]); *(GAS f32x4*)(A.out + O_MC + so * 16384 + el) = fin; }
              else { *(GAS f32x4*)(SIN + un1 * 128 + (el - 16384)) = (f32x4){z_, z_, z_, z_}; *(GAS f32x4*)(SIN + un2 * 128 + (el - 16384)) = u1[k]; *(GAS f32x4*)(A.out + O_MN + so * 128 + (el - 16384)) = fin; }
              if (el == 0) { SIM[un1] = -INFINITY; SIM[un2] = m1; A.out[O_MM + so] = mn; } } }
      } }
}

__device__ __forceinline__ void p5_mlstm_out_unit(CArgs& A, Frame& F, const int l, const int cu, unsigned* queue) {
    int tid_o = F.tid; asm volatile("" : "+v"(tid_o));
    const int tid = tid_o, lane = tid & 63, w = F.wave, fr = lane & 15, fq = lane >> 4;
    const int h = cu & 3, cg = cu >> 2, row0 = cg * 128;
    LAS bf16* P = (LAS bf16*)(F.lds + RING_OFF); LAS unsigned char* CI = F.lds + RING_OFF + 34816; LAS unsigned char* VI = CI + 32768;
    LAS bf16* NB = (LAS bf16*)(F.lds + RING_OFF + 100352);
    LAS float* arr = (LAS float*)(F.lds + RING_OFF + 100608);
    LAS float* igf = arr, *lff = arr + 128, *igb = arr + 256, *lfb = arr + 384;
    const int s0 = tid >> 4, ch = tid & 15;
    const int unit0 = (cg * 4 + h) * 2;
    bf16x8 vvv[4], kkk[4], qa[4], cv0[4], cv1[4];
#pragma unroll
    for (int i = 0; i < 4; ++i) vvv[i] = *(const bf16x8*)(((bf16*)(A.ws + WS_PROJ)) + (size_t)(row0 + s0 + 32 * i) * NIN + C_MV + h * 128 + ch * 8);
#pragma unroll
    for (int i = 0; i < 4; ++i) kkk[i] = *(const bf16x8*)(((bf16*)(A.ws + WS_PROJ)) + (size_t)(row0 + s0 + 32 * i) * NIN + C_MK + h * 128 + ch * 8);
#pragma unroll
    for (int ks = 0; ks < 4; ++ks) qa[ks] = *(const bf16x8*)(((bf16*)(A.ws + WS_PROJ)) + (size_t)(row0 + 16 * w + fr) * NIN + C_MQ + h * 128 + ks * 32 + fq * 8);
#pragma unroll
    for (int i = 0; i < 4; ++i) cv0[i] = *(const bf16x8*)(((bf16*)(A.ws + WS_SIC)) + (size_t)unit0 * 16384 + (s0 + 32 * i) * 128 + ch * 8);
#pragma unroll
    for (int i = 0; i < 4; ++i) cv1[i] = *(const bf16x8*)(((bf16*)(A.ws + WS_SIC)) + (size_t)(unit0 + 1) * 16384 + (s0 + 32 * i) * 128 + ch * 8);
    float g0_ = 0.f, g1_ = 0.f, g2_ = 0.f, g3_ = 0.f, n0_ = 0.f, n1_ = 0.f;
    if (tid < 128) { const float* pr = ((const float*)(A.ws + WS_GATES)) + (size_t)(row0 + tid) * 16 + h; g0_ = pr[0]; g1_ = pr[4]; g2_ = pr[8]; g3_ = pr[12];
        n0_ = ((float*)(A.ws + WS_SIN))[unit0 * 128 + tid]; n1_ = ((float*)(A.ws + WS_SIN))[(unit0 + 1) * 128 + tid]; }
    unsigned tk_ = 0u; if (tid == 0) tk_ = xb_add(queue, 1u);
    __builtin_amdgcn_sched_barrier(0);
    __syncthreads();
    if (tid == 0) F.MISC[14] = tk_;
    if (tid < 128) { const float* gb = A.in[17] + l * 16 + h;
        igf[tid] = g0_ + gb[0]; lff[tid] = logsigf(g1_ + gb[4]); igb[tid] = g2_ + gb[8]; lfb[tid] = logsigf(g3_ + gb[12]); NB[tid] = (bf16)f2bf(n0_); }
#pragma unroll
    for (int i = 0; i < 4; ++i) *(LAS bf16x8*)(P + (s0 + 32 * i) * 136 + ch * 8) = kkk[i];
#pragma unroll
    for (int i = 0; i < 4; ++i) { const int s = s0 + 32 * i; *(LAS bf16x8*)(VI + (unsigned)(s >> 5) * 8192u + dui_off_b((unsigned)(s & 31), (unsigned)ch)) = vvv[i]; }
#pragma unroll
    for (int i = 0; i < 4; ++i) { const int dd = s0 + 32 * i; *(LAS bf16x8*)(CI + (unsigned)(dd >> 5) * 8192u + dui_off_b((unsigned)(dd & 31), (unsigned)ch)) = cv0[i]; }
    __syncthreads();
    if (w < 2) {
        const int d = w; const int unit = unit0 + d;
        const float m_in = ((float*)(A.ws + WS_SIM))[unit];
        LAS float* igp = d ? igb : igf; LAS float* lfp = d ? lfb : lff;
        LAS float* rowt = arr + 512 + d * 512; LAS float* colt = rowt + 128; LAS float* ain = rowt + 256; LAS float* flo = rowt + 384;
        const int j0 = d ? 127 - 2 * lane : 2 * lane, j1 = d ? 126 - 2 * lane : 2 * lane + 1;
        float bc0, bc1; wave_scan_add2(lfp[j0], lfp[j1], lane, bc0, bc1);
        const float ct0 = igp[j0] - bc0, ct1 = igp[j1] - bc1;
        float pm0, pm1; wave_scan_max2(ct0, ct1, lane, pm0, pm1);
        { const float inter = bc0 + m_in, mr = fmaxf(inter, bc0 + pm0); colt[j0] = ct0; rowt[j0] = bc0 - mr; ain[j0] = __expf(inter - mr); flo[j0] = __expf(-mr); }
        { const float inter = bc1 + m_in, mr = fmaxf(inter, bc1 + pm1); colt[j1] = ct1; rowt[j1] = bc1 - mr; ain[j1] = __expf(inter - mr); flo[j1] = __expf(-mr); }
    }
    f32x4 sacc[8];
#pragma unroll
    for (int sh = 0; sh < 2; ++sh) { bf16x8 kbv[16];
#pragma unroll
        for (int i = 0; i < 16; ++i) kbv[i] = *(const LAS bf16x8*)(P + (16 * (sh * 4 + (i >> 2)) + fr) * 136 + (i & 3) * 32 + fq * 8);
        __builtin_amdgcn_sched_barrier(0);
#pragma unroll
        for (int i = 0; i < 16; ++i) { const int st = sh * 4 + (i >> 2); if ((i & 3) == 0) sacc[st] = (f32x4){0.f, 0.f, 0.f, 0.f}; sacc[st] = MFMA16(qa[i & 3], kbv[i], sacc[st]); } }
    f32x4 hsum[8];
#pragma unroll
    for (int et = 0; et < 8; ++et) hsum[et] = (f32x4){0.f, 0.f, 0.f, 0.f};
    unsigned ta[8][2];
#pragma unroll
    for (int c = 0; c < 8; ++c) { ta[c][0] = (unsigned)(uintptr_t)CI + tr16_addr((unsigned)lane, (unsigned)c, 0u); ta[c][1] = (unsigned)(uintptr_t)CI + tr16_addr((unsigned)lane, (unsigned)c, 1u); }
    const bf16x8 zero8 = (bf16x8){0, 0, 0, 0, 0, 0, 0, 0};
    const bf16x8 ones = (fr == 0) ? (bf16x8){0x3F80, 0x3F80, 0x3F80, 0x3F80, 0x3F80, 0x3F80, 0x3F80, 0x3F80} : zero8;
    for (int d = 0; d < 2; ++d) {
        const int unit = (cg * 4 + h) * 2 + d;
        LAS float* rowt = arr + 512 + d * 512; LAS float* colt = rowt + 128; LAS float* ain = rowt + 256; LAS float* flo = rowt + 384;
        __syncthreads();
        if (d == 1) {
#pragma unroll
          for (int i = 0; i < 4; ++i) { const int dd = s0 + 32 * i; *(LAS bf16x8*)(CI + (unsigned)(dd >> 5) * 8192u + dui_off_b((unsigned)(dd & 31), (unsigned)ch)) = cv1[i]; }
          if (tid < 128) NB[tid] = (bf16)f2bf(n1_); }
        float rt[4];
#pragma unroll
        for (int r = 0; r < 4; ++r) rt[r] = rowt[16 * w + fq * 4 + r];
#pragma unroll
        for (int st = 0; st < 8; ++st) { const int s = 16 * st + fr; const float ct = colt[s];
#pragma unroll
            for (int r = 0; r < 4; ++r) { const int j = 16 * w + fq * 4 + r; const bool ok = d ? (s >= j) : (s <= j);
                const float p = ok ? sacc[st][r] * KSCALE * __expf(rt[r] + ct) : 0.f; P[j * 136 + s] = (bf16)f2bf(p); } }
        __syncthreads();
        f32x4 acc[9];
#pragma unroll
        for (int et = 0; et < 9; ++et) acc[et] = (f32x4){0.f, 0.f, 0.f, 0.f};
#define P5_KSTEP(KS, IMGOFF, AF, B9) do { \
            s16x4v bl[8], bh[8]; \
            _Pragma("unroll") for (int c = 0; c < 8; ++c) { bl[c] = tr16_read<(IMGOFF) + (KS) * 8192>(ta[c][0]); bh[c] = tr16_read<(IMGOFF) + (KS) * 8192>(ta[c][1]); } \
            asm volatile("s_waitcnt lgkmcnt(0)" ::: "memory"); __builtin_amdgcn_sched_barrier(0); \
            _Pragma("unroll") for (int c = 0; c < 8; ++c) acc[c] = MFMA16(AF, TR_PK(bl[c], bh[c]), acc[c]); \
            acc[8] = MFMA16(AF, B9, acc[8]); } while (0)
        { bf16x8 nf[4];
#pragma unroll
          for (int ks = 0; ks < 4; ++ks) { const bf16x8 nv = *(const LAS bf16x8*)(NB + ks * 32 + fq * 8); nf[ks] = (fr == 0) ? nv : zero8; }
          P5_KSTEP(0, 0, qa[0], nf[0]); P5_KSTEP(1, 0, qa[1], nf[1]); P5_KSTEP(2, 0, qa[2], nf[2]); P5_KSTEP(3, 0, qa[3], nf[3]); }
        float ai[4], fl[4];
#pragma unroll
        for (int r = 0; r < 4; ++r) { ai[r] = ain[16 * w + fq * 4 + r]; fl[r] = flo[16 * w + fq * 4 + r]; }
#pragma unroll
        for (int et = 0; et < 9; ++et)
#pragma unroll
            for (int r = 0; r < 4; ++r) acc[et][r] *= ai[r];
        { bf16x8 pa[4];
#pragma unroll
          for (int ks = 0; ks < 4; ++ks) pa[ks] = *(const LAS bf16x8*)(P + (16 * w + fr) * 136 + ks * 32 + fq * 8);
          P5_KSTEP(0, 32768, pa[0], ones); P5_KSTEP(1, 32768, pa[1], ones); P5_KSTEP(2, 32768, pa[2], ones); P5_KSTEP(3, 32768, pa[3], ones); }
#undef P5_KSTEP
#pragma unroll
        for (int r = 0; r < 4; ++r) { const float den = __shfl(acc[8][r], lane & 48); const float inv = 1.f / fmaxf(fabsf(den), fl[r]);
#pragma unroll
            for (int et = 0; et < 8; ++et) hsum[et][r] += acc[et][r] * inv; }
    }
#pragma unroll
    for (int r = 0; r < 4; ++r) { float ss = 0.f;
#pragma unroll
        for (int et = 0; et < 8; ++et) ss += hsum[et][r] * hsum[et][r];
        ss += __shfl_xor(ss, 1); ss += __shfl_xor(ss, 2); ss += __shfl_xor(ss, 4); ss += __shfl_xor(ss, 8);
        const float rn = rsqrtf(ss * (1.f / 128.f) + EPS); const int row = row0 + 16 * w + fq * 4 + r;
#pragma unroll
        for (int et = 0; et < 8; ++et) { const int e = 16 * et + fr; const float g = A.in[18][(l * 4 + h) * 128 + e]; const float mo = bf2f(((bf16*)(A.ws + WS_PROJ))[(size_t)row * NIN + C_MO + h * 128 + e]);
            ((bf16*)(A.ws + WS_CAT))[(size_t)row * DM + 1024 + h * 128 + e] = (bf16)f2bf(hsum[et][r] * rn * g / (1.f + __expf(-mo))); } }
}

__device__ __forceinline__ void p5_attention(CArgs& A, Frame& F, const int F_L, char* lds) {
    const float L2E = 1.4426950408889634f;
    const float* lv = A.in[19] + F_L * 256;
    const float lam_init = 0.8f - 0.6f * expf(-0.3f * (float)F_L);
    const float lam = expf(wave_sum(lv[F.lane] * lv[64 + F.lane])) - expf(wave_sum(lv[128 + F.lane] * lv[192 + F.lane])) + lam_init;
    bf16* PROJ = (bf16*)(A.ws + WS_PROJ); bf16* KB = (bf16*)(A.ws + WS_KB); bf16* VB = (bf16*)(A.ws + WS_VB); bf16* CAT = (bf16*)(A.ws + WS_CAT); bf16* OD = (bf16*)(A.ws + WS_OD);
    for (int slot = F.vcu; slot < 256; slot += F.G) {
        for (int item = 0; item < 4; ++item) {
            if (slot >= 128 && item >= 1) break;
            const bool lat = item == 0; const int seq = lat ? LATKV : 256;
            const bool dif = (slot < 128) && (item <= 1);
            if (dif) {
                int row0, krow0, hd, t0;
                if (lat) { const int b = slot >> 6, qb = slot & 15; hd = (slot >> 4) & 3; row0 = MCTX + b * 4096 + qb * 256; krow0 = MCTX + b * LATKV; t0 = qb * 256; }
                else { const int b = slot >> 2; hd = slot & 3; row0 = b * 256; krow0 = b * 256; t0 = 0; }
                const bf16* Q = PROJ + (size_t)row0 * NIN + C_DQ + hd * 128; const bf16* K = KB + (size_t)krow0 * KVW + 256 + hd * 128; const bf16* V = VB + (size_t)krow0 * KVW + 256 + hd * 128;
                bf16* O1 = OD + (size_t)row0 * DM + hd * 128; bf16* O = CAT + (size_t)row0 * DM + 1536 + hd * 128;
                __syncthreads();
                att::attn_dense_body<true>(Q, NIN, 1, nullptr, lat ? 1 : 0, t0, K, V, KVW, O1, DM, seq, 0.125f * L2E, 8.f / 0.125f, lds);
                __syncthreads();
                att::attn_dense_body<true>(Q, NIN, 2, nullptr, lat ? 1 : 0, t0, K, V, KVW, O, DM, seq, 0.125f * L2E, 8.f / 0.125f, lds, O1, lam, A.in[20] + F_L * 128, 1.f - lam_init);
            } else {
                const int nu = lat ? 2 : 1;
                for (int k2 = 0; k2 < nu; ++k2) {
                    const int u = lat ? (slot - 128) * 2 + k2 : slot * 2 + (item - 2);
                    int row0, krow0, hh, t0;
                    if (lat) { const int b = u >> 7, qb = u & 15; hh = (u >> 4) & 7; row0 = MCTX + b * 4096 + qb * 256; krow0 = MCTX + b * LATKV; t0 = qb * 256; }
                    else { const int b = u >> 3; hh = u & 7; row0 = b * 256; krow0 = b * 256; t0 = 0; }
                    const bf16* Q = PROJ + (size_t)row0 * NIN + C_AQ + hh * 128; const bf16* K = KB + (size_t)krow0 * KVW + (hh >> 2) * 128; const bf16* V = VB + (size_t)krow0 * KVW + (hh >> 2) * 128;
                    bf16* O = CAT + (size_t)row0 * DM + hh * 128;
                    __syncthreads();
                    att::attn_dense_body<false>(Q, NIN, 0, A.in[16] + F_L * 256, lat ? 1 : 0, t0, K, V, KVW, O, DM, seq, 0.08838834764831845f * L2E, 8.f / 0.08838834764831845f, lds);
                }
            }
        }
    }
}

__global__ void __launch_bounds__(NWAVES * 64, 2) mega_fwd(Args args) {
    extern __shared__ __attribute__((aligned(16))) unsigned char lds[];
    Frame F;
    F.lds = (LAS unsigned char*)lds;
    F.MISC = (volatile LAS unsigned*)(F.lds + MISC_OFF);
    F.tid = threadIdx.x; F.lane = F.tid & 63; F.wave = __builtin_amdgcn_readfirstlane(F.tid >> 6);
    F.G = gridDim.x; { const int bx = blockIdx.x; F.vcu = (F.G % 8 == 0) ? (bx % 8) * (F.G / 8) + bx / 8 : bx; }
    F.ctl = (gu32*)(args.ws + WS_CTL);
#define A (*kargs())
    for (int u = F.tid; u < (LDS_BYTES - LDSCTL_OFF) / 4; u += NWAVES * 64) ((LAS unsigned*)(F.lds + LDSCTL_OFF))[u] = 0u;
    __syncthreads();
    (void)xcd_barrier_post((unsigned*)(F.ctl + CW_BAR), F.MISC + 8);
    if (F.tid == 0) ((unsigned*)(F.ctl + CW_XCC))[blockIdx.x] = xb_xcc_id() + 1u;
    F.gmode = 0; F.rbase = F.vcu * NWAVES; F.rend = M; F.rstep = F.G * NWAVES; F.gtile = 0;
    unsigned gbn = 0;
#define GRID_BAR() for (int rb_ = 0; rb_ < REP_BAR; ++rb_) do { XcdBarrier b_; b_.bar = (unsigned*)(A.ws + WS_CTL) + CW_BAR; b_.x = xb_xcc_id(); b_.st = (volatile LAS unsigned*)(F.lds + MISC_OFF) + 8; xcd_barrier(b_); } while (0)

    const int plim = args.limit; int pc = 0;
#define PH_ON() (pc++ < plim)
        if (PH_ON()) {
#ifndef X_P0
    for (int rep_ = 0; rep_ < REP_P0; ++rep_) p0_prologue(A, F);
#endif
    GRID_BAR();
        }
#ifndef NO_GROUP_MODE
    { int ok = (F.G == 256) ? 1 : 0;
      if (ok && F.tid < 64) { const unsigned* xc = (const unsigned*)(F.ctl + CW_XCC); const int x = F.tid & 7, j = F.tid >> 3;
          const unsigned id0 = __hip_atomic_load(xc + x + 8 * j, RLX_AGENT); ok = id0 != 0u;
#pragma unroll
          for (int k = 1; k < 4; ++k) ok &= (__hip_atomic_load(xc + x + 8 * (j + 8 * k), RLX_AGENT) == id0) ? 1 : 0; }
      const int all_ok = __syncthreads_and(ok);
      if (all_ok) { const int c = (int)blockIdx.x; const int panel = 8 * (c % 8) + (c / 8) % 8, kq = c / 64;
          F.gmode = 1; F.rbase = panel * 256 + kq * 64; F.rstep = 1; F.gtile = (panel * 256 + kq * 64) / 16; } }
#endif
#define SEAM() do { if (F.gmode) { const int c_ = (int)blockIdx.x; ++gbn; grp_barrier((unsigned*)(A.ws + WS_CTL) + CW_GRP + 64 * (8 * (c_ % 8) + (c_ / 8) % 8), 4u * gbn, (unsigned*)(A.ws + WS_CTL) + CW_BAR + XB_TMO); } else GRID_BAR(); } while (0)
        if (PH_ON()) {
    for (int rep_ = 0; rep_ < REP_T1; ++rep_) row_phase(A, F, nullptr, nullptr, nullptr, 0, 0, true, A.in[13] + 0, ((float*)(A.ws + WS_MOD)) + 2048, ((float*)(A.ws + WS_MOD)) + 0);
    SEAM();
        }
    for (int l = 0; l < NL; ++l) {
        { int t_ = threadIdx.x; asm volatile("" : "+v"(t_)); F.tid = t_; F.lane = t_ & 63; F.wave = __builtin_amdgcn_readfirstlane(t_ >> 6); }
        const float* mod = ((float*)(A.ws + WS_MOD)) + (size_t)l * 3 * 12288; const float* ng = A.in[13] + (size_t)l * 4 * DM;
        if (PH_ON()) {
        { pg8::Gemm g{((bf16*)(A.ws + WS_HN)), wptr(A, l, W_IN), M, C_MG, DM}; pg8::StaticOrder S; S.init(M, C_MG, F.G, (int)blockIdx.x);
          pg8::EpiBf16<0> E{((bf16*)(A.ws + WS_PROJ)), NIN};
#ifndef X_GEMM
          for (int rep_ = 0; rep_ < REP_GEMM; ++rep_) pg8::gemm_phase<pg8::EpiBf16<0>, pg8::StaticOrder, true, true>(F.lds + RING_OFF, g, S, E);
#endif
 }
        gates_part(A, F, l);
        GRID_BAR();
        }
        if (PH_ON()) {
#ifndef X_P2
        for (int rep_ = 0; rep_ < REP_P2; ++rep_) p2_postproj(A, F, l);
#endif
#ifndef X_P3
        p3_summary_units(A, F, l, REP_ML * REP_P3);
#endif
        GRID_BAR();
        }
        if (PH_ON()) {
#ifndef X_P4
        for (int rep_ = 0; rep_ < REP_ML; ++rep_) p4_scan(A, F, l);
#endif
        dep_signal((unsigned*)(A.ws + WS_CTL) + CW_DEP + 64 * l);
        }
        if (PH_ON()) {
#ifndef X_P5A
        for (int rep_ = 0; rep_ < REP_ATT; ++rep_) p5_attention(A, F, l, (char*)lds + RING_OFF);
#endif
        dep_wait((unsigned*)(A.ws + WS_CTL) + CW_DEP + 64 * l, (unsigned)F.G, (unsigned*)(A.ws + WS_CTL) + CW_BAR + XB_TMO);
        { int t_ = threadIdx.x; asm volatile("" : "+v"(t_)); F.tid = t_; F.lane = t_ & 63; F.wave = __builtin_amdgcn_readfirstlane(t_ >> 6); }
#ifndef X_P5M
        if (F.tid == 0) F.MISC[14] = xb_add((unsigned*)(A.ws + WS_CTL) + CW_DEP + 64 * l + 16, 1u);
        for (;;) {
            __syncthreads();
            const int u = (int)F.MISC[14];
            if (u >= 512 * REP_ML) break;
            p5_mlstm_out_unit(A, F, l, u & 511, (unsigned*)(A.ws + WS_CTL) + CW_DEP + 64 * l + 16);
        }
#endif
        GRID_BAR();
        }
        if (PH_ON()) {
        { pg8::Gemm g{((bf16*)(A.ws + WS_CAT)), wptr(A, l, W_OUT), M, DM, DM}; pg8::StaticOrder S; S.init(M, DM, F.G, (int)blockIdx.x);
          pg8::EpiBf16<0> E{((bf16*)(A.ws + WS_MIX)), DM};
#ifndef X_GEMM
          for (int rep_ = 0; rep_ < REP_GEMM; ++rep_) pg8::gemm_phase<pg8::EpiBf16<0>, pg8::StaticOrder, true, true>(F.lds + RING_OFF, g, S, E);
#endif
 }
        SEAM();
        }
        if (PH_ON()) {
        row_phase(A, F, ((bf16*)(A.ws + WS_MIX)), ng + DM, mod + 4096, (l == 0) ? 0 : 1, 0, true, ng + 2 * DM, mod + 8192, mod + 6144);
        SEAM();
        }
        if (PH_ON()) {
        { pg8::Gemm g{((bf16*)(A.ws + WS_HN)), wptr(A, l, W_1), M, DFF, DM}; pg8::StaticOrder S; S.init(M, DFF, F.G, (int)blockIdx.x);
          pg8::EpiBf16<2> E{((bf16*)(A.ws + WS_H)), DFF};
#ifndef X_GEMM
          for (int rep_ = 0; rep_ < REP_GEMM; ++rep_) pg8::gemm_phase<pg8::EpiBf16<2>, pg8::StaticOrder, true, true>(F.lds + RING_OFF, g, S, E);
#endif
 }
        SEAM();
        }
        if (PH_ON()) {
        { pg8::Gemm g{((bf16*)(A.ws + WS_H)), wptr(A, l, W_2), M, DM, DFF}; pg8::StaticOrder S; S.init(M, DM, F.G, (int)blockIdx.x);
          pg8::EpiBf16<0> E{((bf16*)(A.ws + WS_MIX)), DM};
#ifndef X_GEMM
          for (int rep_ = 0; rep_ < REP_GEMM; ++rep_) pg8::gemm_phase<pg8::EpiBf16<0>, pg8::StaticOrder, true, true>(F.lds + RING_OFF, g, S, E);
#endif
 }
        SEAM();
        }
        if (PH_ON()) {
        { const int ln = (l + 1 < NL) ? l + 1 : l; const float* modn = ((float*)(A.ws + WS_MOD)) + (size_t)ln * 3 * 12288; const float* ngn = A.in[13] + (size_t)ln * 4 * DM;
          row_phase(A, F, ((bf16*)(A.ws + WS_MIX)), ng + 3 * DM, mod + 10240, 1, (l + 1 < NL) ? 0 : 1, l + 1 < NL, ngn, modn + 2048, modn + 0); }
        if (l + 1 < NL) SEAM();
        }
    }
}

#undef A
extern "C" void kernel_launch(void* const* d_in, const int* in_sizes, int n_in, void* d_out, int out_size, void* d_ws, size_t ws_size, hipStream_t stream) {
    static int grid = 0;
    if (grid == 0) {
        if (n_in != 23 || (size_t)out_size != O_END || ws_size < WS_END) { fprintf(stderr, "kernel_launch: shape mismatch n_in %d out %d ws %zu\n", n_in, out_size, ws_size); grid = -1; return; }
        int dev = 0, cus = 0, per_cu = 0;
        if (hipGetDevice(&dev) != hipSuccess || hipDeviceGetAttribute(&cus, hipDeviceAttributeMultiprocessorCount, dev) != hipSuccess) { grid = -1; return; }
        if (hipFuncSetAttribute((const void*)mega_fwd, hipFuncAttributeMaxDynamicSharedMemorySize, LDS_BYTES) != hipSuccess) { fprintf(stderr, "kernel_launch: hipFuncSetAttribute failed\n"); grid = -1; return; }
        if (hipOccupancyMaxActiveBlocksPerMultiprocessor(&per_cu, (const void*)mega_fwd, NWAVES * 64, LDS_BYTES) != hipSuccess || per_cu < 1)
            fprintf(stderr, "kernel_launch: note: occupancy query reports %d workgroups per CU\n", per_cu);
        (void)hipGetLastError();
        grid = cus;
    }
    if (grid < 0) return;
    if (hipMemsetAsync((char*)d_ws + WS_CTL, 0, CTL_ZERO_BYTES, stream) != hipSuccess) return;
    Args a{}; a.limit = 1000000; a.pad = 0;
    for (int i = 0; i < 23; ++i) a.in[i] = (const float*)d_in[i];
    a.out = (float*)d_out; a.ws = (unsigned char*)d_ws;
    hipLaunchKernelGGL(mega_fwd, dim3(grid), dim3(NWAVES * 64), LDS_BYTES, stream, a);
#ifdef PROBE_LIMIT
    (void)hipMemsetAsync((char*)d_ws + WS_CTL, 0, CTL_ZERO_BYTES, stream);
    a.limit = PROBE_LIMIT;
    hipLaunchKernelGGL(mega_fwd, dim3(grid), dim3(NWAVES * 64), LDS_BYTES, stream, a);
#endif
    const hipError_t le = hipPeekAtLastError();
    if (le != hipSuccess) fprintf(stderr, "kernel_launch: launch failed: %s\n", hipGetErrorName(le));
}
```
